# Optimizing an MI355X kernel written in HIP

```python
import math, functools
import jax, jax.numpy as jnp
from jax import lax
import numpy as np

D_MODEL = 1024
BATCH = 8
SEQ = 4096
DEPTH = 1
DEC_BATCH = 32
DEC_SEQ = 32
PAST_LEN = 4096

CHUNK = 64
Q_BLOCK = 128
SB_HEADS = 8
SB_HEAD_DIM = 64
SB_WIDTH = SB_HEADS * SB_HEAD_DIM
SB_SCALE = SB_HEAD_DIM ** -0.5
HG_HEADS = 4
HG_KEY_DIM = 128
HG_VAL_DIM = 128
HG_KEY_WIDTH = HG_HEADS * HG_KEY_DIM
HG_VAL_WIDTH = HG_HEADS * HG_VAL_DIM
MIX_WIDTH = SB_WIDTH + HG_VAL_WIDTH
IN_WIDTHS = (SB_WIDTH, SB_WIDTH, SB_WIDTH, HG_KEY_WIDTH, HG_KEY_WIDTH, HG_VAL_WIDTH, HG_VAL_WIDTH)
IN_WIDTH = sum(IN_WIDTHS)
IN_SPLIT_POINTS = tuple(int(v) for v in np.cumsum(IN_WIDTHS)[:-1])
D_FF = 2816
EPS = 1e-6

kernel_name = "stickbreak_hgrn2_macaron_stream_step"


def rms_norm(x, g):
    xf = x.astype(jnp.float32)
    y = xf * lax.rsqrt(jnp.mean(xf * xf, axis=-1, keepdims=True) + EPS)
    return (y * g.astype(jnp.float32)).astype(x.dtype)


def swiglu(x, w_in, w_out):
    a, b = jnp.split(x @ w_in, 2, axis=-1)
    return (jax.nn.silu(a) * b) @ w_out


def sb_attend(q, k, v, q_pos, k_pos):
    z = jnp.einsum('bqhd,bkhd->bhqk', q.astype(jnp.float32), k.astype(jnp.float32)) * SB_SCALE
    mask = k_pos[None, :] < q_pos[:, None]
    log_beta = jax.nn.log_sigmoid(z)
    log_keep = jnp.where(mask, jax.nn.log_sigmoid(-z), 0.0)
    tail = lax.cumsum(log_keep, axis=3, reverse=True) - log_keep
    w = jnp.where(mask, jnp.exp(log_beta + tail), 0.0)
    return jnp.einsum('bhqk,bkhd->bqhd', w.astype(v.dtype), v)


def sb_prompt(q, k, v):
    B, T = q.shape[0], q.shape[1]
    n_blocks = T // Q_BLOCK
    k_pos = jnp.arange(T)

    def one_block(i):
        start = i * Q_BLOCK
        qb = lax.dynamic_slice_in_dim(q, start, Q_BLOCK, axis=1)
        return sb_attend(qb, k, v, start + jnp.arange(Q_BLOCK), k_pos)

    out = lax.map(one_block, jnp.arange(n_blocks))
    return out.transpose(1, 0, 2, 3, 4).reshape(B, T, SB_HEADS, SB_HEAD_DIM)


def sb_sample(q, k, v, ck, cv):
    P, T = ck.shape[1], q.shape[1]
    k_all = jnp.concatenate([ck.astype(k.dtype), k], axis=1)
    v_all = jnp.concatenate([cv.astype(v.dtype), v], axis=1)
    return sb_attend(q, k_all, v_all, P + jnp.arange(T), jnp.arange(P + T))


def hgrn2_scan(q, k, v, log_f, S0, chunk):
    B, T, H, dk = q.shape
    dv = v.shape[-1]
    n = T // chunk

    def to_chunks(a):
        return a.reshape(B, n, chunk, H, a.shape[-1]).transpose(1, 0, 3, 2, 4)

    qc, kc, vc, gc = to_chunks(q), to_chunks(k), to_chunks(v), to_chunks(log_f)
    causal = jnp.tril(jnp.ones((chunk, chunk), dtype=bool))

    def step(S, inp):
        qi, ki, vi, gi = inp
        b = jnp.cumsum(gi, axis=2)
        o_inter = jnp.einsum('bhtc,bhcv->bhtv', qi * jnp.exp(b), S)
        diff = b[:, :, :, None, :] - b[:, :, None, :, :]
        decay = jnp.exp(jnp.where(causal[:, :, None], diff, -jnp.inf))
        att = jnp.einsum('bhtc,bhsc,bhtsc->bhts', qi, ki, decay)
        o = o_inter + jnp.einsum('bhts,bhsv->bhtv', att, vi)
        b_last = b[:, :, -1:, :]
        S_new = jnp.exp(b_last[:, :, 0, :])[..., None] * S + jnp.einsum(
            'bhsc,bhsv->bhcv', ki * jnp.exp(b_last - b), vi)
        return S_new, o

    S_fin, o = lax.scan(step, S0.astype(jnp.float32), (qc, kc, vc, gc))
    o = o.transpose(1, 0, 3, 2, 4).reshape(B, T, H, dv)
    return o, S_fin


def _layer(x, ffn1_norm, ffn1_w_in, ffn1_w_out, mix_norm, w_in, sb_q_gain, sb_k_gain,
           lb, sb_out_gain, hg_out_gain, w_out, ffn2_norm, ffn2_w_in, ffn2_w_out,
           sb_mix, S0, hg_chunk):
    B, T, _ = x.shape
    x = x + 0.5 * swiglu(rms_norm(x, ffn1_norm), ffn1_w_in, ffn1_w_out)
    h = rms_norm(x, mix_norm)
    sq, sk, sv, hq, hf, hi, hg = jnp.split(h @ w_in, IN_SPLIT_POINTS, axis=-1)

    def heads(a, n):
        return a.reshape(B, T, n, a.shape[-1] // n)

    sq = rms_norm(heads(sq, SB_HEADS), sb_q_gain)
    sk = rms_norm(heads(sk, SB_HEADS), sb_k_gain)
    sv = heads(sv, SB_HEADS)
    sb_o = rms_norm(sb_mix(sq, sk, sv), sb_out_gain).reshape(B, T, SB_WIDTH)
    hf32 = hf.astype(jnp.float32)
    f = lb + (1.0 - lb) * jax.nn.sigmoid(hf32)
    log_f = jnp.log(f)
    k_in = (1.0 - lb) * jax.nn.sigmoid(-hf32)
    q_h = jax.nn.silu(hq.astype(jnp.float32))
    o_h, S_new = hgrn2_scan(heads(q_h, HG_HEADS), heads(k_in, HG_HEADS),
                            heads(hi.astype(jnp.float32), HG_HEADS), heads(log_f, HG_HEADS),
                            S0, hg_chunk)
    o_h = rms_norm(o_h, hg_out_gain) * jax.nn.silu(heads(hg, HG_HEADS).astype(jnp.float32))
    mix = jnp.concatenate([sb_o, o_h.reshape(B, T, HG_VAL_WIDTH).astype(x.dtype)], axis=-1)
    x = x + mix @ w_out
    x = x + 0.5 * swiglu(rms_norm(x, ffn2_norm), ffn2_w_in, ffn2_w_out)
    return x, sk, sv, S_new.astype(x.dtype)


def setup_inputs(seed: int = 0) -> dict:
    key = jax.random.key(seed)
    ks = jax.random.split(key, 20)

    def nrm(k, shape, scale):
        return jax.random.normal(k, shape, jnp.float32) * scale

    def gain(k, shape):
        return 1.0 + 0.05 * jax.random.normal(k, shape, jnp.float32)

    return {
        "x_prompt": nrm(ks[0], (BATCH, SEQ, D_MODEL), 1.0),
        "x_sample": nrm(ks[1], (DEC_BATCH, DEC_SEQ, D_MODEL), 1.0),
        "cache_sb_k": nrm(ks[2], (DEPTH, DEC_BATCH, PAST_LEN, SB_HEADS, SB_HEAD_DIM), 1.0),
        "cache_sb_v": nrm(ks[3], (DEPTH, DEC_BATCH, PAST_LEN, SB_HEADS, SB_HEAD_DIM), 1.0),
        "state_hgrn": nrm(ks[4], (DEPTH, DEC_BATCH, HG_HEADS, HG_KEY_DIM, HG_VAL_DIM), 0.5),
        "ffn1_norm": gain(ks[5], (DEPTH, D_MODEL)),
        "ffn1_w_in": nrm(ks[6], (DEPTH, D_MODEL, 2 * D_FF), D_MODEL ** -0.5),
        "ffn1_w_out": nrm(ks[7], (DEPTH, D_FF, D_MODEL), D_FF ** -0.5),
        "mix_norm": gain(ks[8], (DEPTH, D_MODEL)),
        "w_in": nrm(ks[9], (DEPTH, D_MODEL, IN_WIDTH), D_MODEL ** -0.5),
        "sb_q_gain": gain(ks[10], (DEPTH, SB_HEAD_DIM)),
        "sb_k_gain": gain(ks[11], (DEPTH, SB_HEAD_DIM)),
        "hg_lb_logits": nrm(ks[12], (DEPTH + 1, HG_KEY_WIDTH), 0.5),
        "sb_out_gain": gain(ks[13], (DEPTH, SB_HEAD_DIM)),
        "hg_out_gain": gain(ks[14], (DEPTH, HG_VAL_DIM)),
        "w_out": nrm(ks[15], (DEPTH, MIX_WIDTH, D_MODEL), MIX_WIDTH ** -0.5),
        "ffn2_norm": gain(ks[16], (DEPTH, D_MODEL)),
        "ffn2_w_in": nrm(ks[17], (DEPTH, D_MODEL, 2 * D_FF), D_MODEL ** -0.5),
        "ffn2_w_out": nrm(ks[18], (DEPTH, D_FF, D_MODEL), D_FF ** -0.5),
    }


def reference(x_prompt, x_sample, cache_sb_k, cache_sb_v, state_hgrn,
              ffn1_norm, ffn1_w_in, ffn1_w_out, mix_norm, w_in, sb_q_gain, sb_k_gain,
              hg_lb_logits, sb_out_gain, hg_out_gain, w_out, ffn2_norm, ffn2_w_in, ffn2_w_out):
    lb_all = jnp.cumsum(jax.nn.softmax(hg_lb_logits.astype(jnp.float32), axis=0), axis=0)

    xp, xs = x_prompt, x_sample
    kp_list, vp_list, sp_list, ks_list, vs_list, ss_list = [], [], [], [], [], []
    for l in range(DEPTH):
        w_l = (ffn1_norm[l], ffn1_w_in[l], ffn1_w_out[l], mix_norm[l], w_in[l],
               sb_q_gain[l], sb_k_gain[l], lb_all[l], sb_out_gain[l], hg_out_gain[l],
               w_out[l], ffn2_norm[l], ffn2_w_in[l], ffn2_w_out[l])
        S0_p = jnp.zeros((xp.shape[0], HG_HEADS, HG_KEY_DIM, HG_VAL_DIM), jnp.float32)
        xp, kp, vp, sp = _layer(xp, *w_l, sb_mix=sb_prompt, S0=S0_p, hg_chunk=CHUNK)
        sb_mix_s = functools.partial(sb_sample, ck=cache_sb_k[l], cv=cache_sb_v[l])
        xs, kn, vn, sn = _layer(xs, *w_l, sb_mix=sb_mix_s, S0=state_hgrn[l],
                                hg_chunk=xs.shape[1])
        kp_list.append(kp); vp_list.append(vp); sp_list.append(sp)
        ks_list.append(kn); vs_list.append(vn); ss_list.append(sn)

    new_k_prompt = jnp.stack(kp_list, axis=0)
    new_v_prompt = jnp.stack(vp_list, axis=0)
    new_state_prompt = jnp.stack(sp_list, axis=0)
    new_k_sample = jnp.stack(ks_list, axis=0)
    new_v_sample = jnp.stack(vs_list, axis=0)
    new_state_sample = jnp.stack(ss_list, axis=0)
    return (xp, xs, new_k_prompt, new_v_prompt, new_state_prompt,
            new_k_sample, new_v_sample, new_state_sample)
```

```cpp
#include <hip/hip_runtime.h>
#include <hip/hip_cooperative_groups.h>
#include <cstdio>
#include <cstdint>
namespace cg = cooperative_groups;
__device__ __forceinline__ int lane_id() { int r; asm volatile("v_mbcnt_lo_u32_b32 %0, -1, 0\n\tv_mbcnt_hi_u32_b32 %0, -1, %0" : "=&v"(r)); return r; }
namespace pg8 {
#define PG8_LAS __attribute__((address_space(3)))
typedef unsigned short bf16_t;
typedef short bf16x8 __attribute__((ext_vector_type(8)));
typedef float f32x4 __attribute__((ext_vector_type(4)));
typedef unsigned u32x4 __attribute__((ext_vector_type(4)));
constexpr int BM = 256, BK = 64, HALF = 128, HTB = HALF * BK * 2  , STAGE_BYTES = 8 * HTB, NXCD = 8, WGM = 8;

__host__ __device__ __forceinline__ int lds_byte(int r, int c) { const int st = (r >> 4) * 2 + (c >> 5), rr = r & 15, cc = c & 31, ob = rr * 64 + cc * 2; return st * 1024 + (ob ^ (((ob >> 9) & 1) << 5)); }
__host__ __device__ __forceinline__ void stage_rc(int b, int& R, int& C) { const int st = b / 1024, sb = b % 1024, swz = sb ^ (((sb >> 9) & 1) << 5); R = (st >> 1) * 16 + swz / 64; C = (st & 1) * 32 + (swz % 64) / 2; }
__host__ __device__ __forceinline__ int perm32(int rho) { const int n = rho >> 4, i = rho & 15; return 8 * (i >> 2) + 4 * n + (i & 3); }

struct Unit { int pm, pn; int ko = 0, sl = 0; };
struct Gemm { const bf16_t* A; const bf16_t* Bt; int M, N, K, KT; };

struct StaticOrder {
    int nM, nN, nwg, G, c;
    __host__ __device__ void init(int M, int N, int G_, int c_) { nM = M / BM; nN = N / BM; nwg = nM * nN; G = G_; c = c_; }
    __host__ __device__ bool next(int i, Unit& u) const {
        const long L = (long)i * G + c; if (L >= nwg) return false;
        int wgid = (int)L; { const int q = nwg / NXCD, r = nwg % NXCD, xcd = wgid % NXCD, off = wgid / NXCD; wgid = (xcd < r ? xcd * (q + 1) : r * (q + 1) + (xcd - r) * q) + off; }
        const int nig = WGM * nN, gid = wgid / nig, fm = gid * WGM, gsz = (nM - fm) < WGM ? (nM - fm) : WGM;
        u.pm = fm + ((wgid % nig) % gsz); u.pn = (wgid % nig) / gsz; return true;
    }
    __device__ __forceinline__ void a_ready(const Unit&) const {}
    __device__ __forceinline__ void done(const Unit&) const {}
};

__device__ __forceinline__ unsigned cvt_pk_bf16(float lo, float hi) { unsigned r; asm volatile("v_cvt_pk_bf16_f32 %0, %1, %2" : "=v"(r) : "v"(lo), "v"(hi)); return r; }
typedef float f32x2 __attribute__((ext_vector_type(2)));
template <class Epi, class Sched, bool ALIGN_EPI = false, bool SP2 = false>
__device__ __forceinline__ void gemm_phase(PG8_LAS unsigned char* lds, const Gemm g, const Sched& S, const Epi& E, const int wid) {
    const int lane = lane_id(), tid = wid * 64 + lane, wr = wid >> 2, wc = wid & 3, fr = lane & 15, fq = lane >> 4;
    const int K = g.K, nt = g.KT;
    unsigned voffA[2], voffB[2];
#pragma unroll
    for (int i = 0; i < 2; ++i) { int R, C; stage_rc(tid * 16 + i * 8192, R, C); const int Rb = Epi::PERM ? ((R & ~31) + perm32(R & 31)) : R;
        voffA[i] = (unsigned)(R * K + C) * 2u; voffB[i] = (unsigned)(Rb * K + C) * 2u; }
    const size_t kstep = (size_t)(BK * 2);
    const size_t hstep = (size_t)HALF * K * 2;
    const size_t tstep = 2 * hstep;
    const unsigned ldsw = (unsigned)wid * 1024u;
    const int aoff = lds_byte(wr * 64 + fr, fq * 8), boff = lds_byte(wc * 32 + fr, fq * 8);
#define PG8_SA(b, h) (((b) * 2 + (h)) * HTB)
#define PG8_SB(b, h) ((4 + (b) * 2 + (h)) * HTB)
#define PG8_STAGE(bufoff, gbase, voff) do { _Pragma("unroll") for (int _i = 0; _i < 2; ++_i) \
        __builtin_amdgcn_global_load_lds((const unsigned*)((const char*)(gbase) + (voff)[_i]), (PG8_LAS unsigned*)(lds + (bufoff) + ldsw + _i * 8192), 16, 0, 0); } while (0)
#define PG8_LDA(dst, b, h) do { _Pragma("unroll") for (int m = 0; m < 4; ++m) _Pragma("unroll") for (int k = 0; k < 2; ++k) dst[m][k] = *(const PG8_LAS bf16x8*)(lds + PG8_SA(b, h) + aoff + m * 2048 + k * 1024); } while (0)
#define PG8_LDB(dst, b, h) do { _Pragma("unroll") for (int n = 0; n < 2; ++n) _Pragma("unroll") for (int k = 0; k < 2; ++k) dst[n][k] = *(const PG8_LAS bf16x8*)(lds + PG8_SB(b, h) + boff + n * 2048 + k * 1024); } while (0)
#define PG8_MMA(ai, bj, At, Bt) do { __builtin_amdgcn_s_setprio(1); _Pragma("unroll") for (int m = 0; m < 4; ++m) _Pragma("unroll") for (int n = 0; n < 2; ++n) _Pragma("unroll") for (int k = 0; k < 2; ++k) \
        acc[ai][bj][m][n] = __builtin_amdgcn_mfma_f32_16x16x32_bf16(Bt[n][k], At[m][k], acc[ai][bj][m][n], 0, 0, 0); __builtin_amdgcn_s_setprio(0); } while (0)
#define PG8_WAIT_V(n) asm volatile("s_waitcnt vmcnt(" #n ")" ::: "memory")
#define PG8_WAIT_L(n) asm volatile("s_waitcnt lgkmcnt(" #n ")" ::: "memory")
#define PG8_BAR __builtin_amdgcn_s_barrier()
#define PG8_SCHED __builtin_amdgcn_sched_barrier(0)
    Unit cur, nxt; int ui = 0;
    if (!S.next(0, cur)) return;
    f32x4 acc[2][2][4][2];
#pragma unroll
    for (int a = 0; a < 2; ++a)
#pragma unroll
        for (int b = 0; b < 2; ++b)
#pragma unroll
            for (int m = 0; m < 4; ++m)
#pragma unroll
                for (int n = 0; n < 2; ++n) acc[a][b][m][n] = (f32x4){0.f, 0.f, 0.f, 0.f};
    bf16x8 At[4][2], B0[2][2], B1[2][2];
    const char* cA = (const char*)g.A + (size_t)cur.pm * tstep + cur.ko; const char* cB = (const char*)g.Bt + (size_t)cur.pn * tstep + cur.ko;
    S.a_ready(cur);
    if constexpr (SP2) {
        PG8_STAGE(PG8_SB(0, 0), cB, voffB); PG8_STAGE(PG8_SB(0, 1), cB + hstep, voffB); PG8_STAGE(PG8_SA(0, 0), cA, voffA); PG8_STAGE(PG8_SA(0, 1), cA + hstep, voffA);
        if (wr == 1) PG8_BAR;
        PG8_WAIT_V(2); PG8_BAR;
        PG8_STAGE(PG8_SB(1, 0), cB + kstep, voffB); PG8_STAGE(PG8_SA(1, 0), cA + kstep, voffA); PG8_STAGE(PG8_SB(1, 1), cB + hstep + kstep, voffB);
        PG8_WAIT_V(6); PG8_BAR;
    } else {
        PG8_STAGE(PG8_SB(0, 0), cB, voffB); PG8_STAGE(PG8_SA(0, 0), cA, voffA); PG8_STAGE(PG8_SB(0, 1), cB + hstep, voffB); PG8_STAGE(PG8_SA(0, 1), cA + hstep, voffA);
        if (wr == 1) PG8_BAR;
        PG8_WAIT_V(4); PG8_BAR;
        PG8_STAGE(PG8_SB(1, 0), cB + kstep, voffB); PG8_STAGE(PG8_SA(1, 0), cA + kstep, voffA); PG8_STAGE(PG8_SB(1, 1), cB + hstep + kstep, voffB);
        PG8_WAIT_V(6); PG8_BAR;
    }
    for (;;) {
        const bool has_next = S.next(ui + 1, nxt);
        const char* nA = has_next ? (const char*)g.A + (size_t)nxt.pm * tstep + nxt.ko : cA; const char* nB = has_next ? (const char*)g.Bt + (size_t)nxt.pn * tstep + nxt.ko : cB;
        for (int t = 0; t < nt; t += 2) {
            const bool last = (t == nt - 2);
            const char* a1 = cA + (size_t)(t + 1) * kstep;
            const char* a2 = last ? nA : cA + (size_t)(t + 2) * kstep; const char* b2 = last ? nB : cB + (size_t)(t + 2) * kstep;
            const char* a3 = a2 + kstep; const char* b3 = b2 + kstep;
            if (last && has_next) S.a_ready(nxt);
            if constexpr (SP2) {
            PG8_LDB(B0, 0, 0); PG8_LDB(B1, 0, 1); PG8_SCHED; PG8_LDA(At, 0, 0); PG8_STAGE(PG8_SA(1, 1), a1 + hstep, voffA);
            PG8_WAIT_V(8); PG8_WAIT_L(0); PG8_BAR; PG8_MMA(0, 0, At, B0); PG8_MMA(0, 1, At, B1); PG8_BAR; PG8_SCHED;
            PG8_LDA(At, 0, 1); PG8_STAGE(PG8_SB(0, 0), b2, voffB); PG8_STAGE(PG8_SB(0, 1), b2 + hstep, voffB); PG8_STAGE(PG8_SA(0, 0), a2, voffA);
            PG8_WAIT_V(8); PG8_WAIT_L(0); PG8_BAR; PG8_MMA(1, 0, At, B0); PG8_MMA(1, 1, At, B1); PG8_BAR; PG8_SCHED;
            PG8_LDB(B0, 1, 0); PG8_LDB(B1, 1, 1); PG8_SCHED; PG8_LDA(At, 1, 0); PG8_STAGE(PG8_SA(0, 1), a2 + hstep, voffA);
            PG8_WAIT_V(8); PG8_WAIT_L(0); PG8_BAR; PG8_MMA(0, 0, At, B0); PG8_MMA(0, 1, At, B1); PG8_BAR; PG8_SCHED;
            PG8_LDA(At, 1, 1); PG8_STAGE(PG8_SB(1, 0), b3, voffB); PG8_STAGE(PG8_SB(1, 1), b3 + hstep, voffB); PG8_STAGE(PG8_SA(1, 0), a3, voffA);
            PG8_WAIT_V(8); PG8_WAIT_L(0); PG8_BAR; PG8_MMA(1, 0, At, B0); PG8_MMA(1, 1, At, B1); PG8_BAR; PG8_SCHED;
            } else {
            PG8_LDB(B0, 0, 0); PG8_SCHED; PG8_LDA(At, 0, 0); PG8_STAGE(PG8_SA(1, 1), a1 + hstep, voffA);
            PG8_WAIT_L(8); PG8_BAR; PG8_WAIT_L(0); PG8_MMA(0, 0, At, B0); PG8_BAR; PG8_SCHED;
            PG8_LDB(B1, 0, 1); PG8_STAGE(PG8_SB(0, 0), b2, voffB);
            PG8_BAR; PG8_WAIT_L(0); PG8_MMA(0, 1, At, B1); PG8_BAR;
            PG8_LDA(At, 0, 1); PG8_STAGE(PG8_SA(0, 0), a2, voffA);
            PG8_BAR; PG8_WAIT_L(0); PG8_MMA(1, 0, At, B0); PG8_BAR; PG8_SCHED;
            PG8_STAGE(PG8_SB(0, 1), b2 + hstep, voffB);
            PG8_WAIT_V(6); PG8_BAR; PG8_MMA(1, 1, At, B1); PG8_BAR;
            PG8_LDB(B0, 1, 0); PG8_SCHED; PG8_LDA(At, 1, 0); PG8_STAGE(PG8_SA(0, 1), a2 + hstep, voffA);
            PG8_WAIT_L(8); PG8_BAR; PG8_WAIT_L(0); PG8_MMA(0, 0, At, B0); PG8_BAR; PG8_SCHED;
            PG8_LDB(B1, 1, 1); PG8_STAGE(PG8_SB(1, 0), b3, voffB);
            PG8_BAR; PG8_WAIT_L(0); PG8_MMA(0, 1, At, B1); PG8_BAR;
            PG8_LDA(At, 1, 1); PG8_STAGE(PG8_SA(1, 0), a3, voffA);
            PG8_BAR; PG8_WAIT_L(0); PG8_MMA(1, 0, At, B0); PG8_BAR; PG8_SCHED;
            PG8_STAGE(PG8_SB(1, 1), b3 + hstep, voffB);
            PG8_WAIT_V(6); PG8_BAR; PG8_MMA(1, 1, At, B1); PG8_BAR;
            }
        }
        if constexpr (ALIGN_EPI) { if (wr == 0) PG8_BAR; }
        if constexpr (!Epi::AFTER_DRAIN) { E(acc, cur, wr, wc, fr, fq); S.done(cur); }
        if (!has_next) break;
#pragma unroll
        for (int a = 0; a < 2; ++a)
#pragma unroll
            for (int b = 0; b < 2; ++b)
#pragma unroll
                for (int m = 0; m < 4; ++m)
#pragma unroll
                    for (int n = 0; n < 2; ++n) acc[a][b][m][n] = (f32x4){0.f, 0.f, 0.f, 0.f};
        cur = nxt; cA = nA; cB = nB; ++ui;
        if constexpr (ALIGN_EPI) { if (wr == 1) PG8_BAR; }
    }
    PG8_WAIT_V(0);
    if constexpr (!ALIGN_EPI) { if (wr == 0) PG8_BAR; }
    PG8_BAR;
    if constexpr (Epi::AFTER_DRAIN) { E.fused(acc, cur, wr, wc, fr, fq, lds, wid, lane); S.done(cur); }
#undef PG8_SA
#undef PG8_SB
#undef PG8_STAGE
#undef PG8_LDA
#undef PG8_LDB
#undef PG8_MMA
#undef PG8_WAIT_V
#undef PG8_WAIT_L
#undef PG8_BAR
#undef PG8_SCHED
}
}

constexpr int DM = 1024, NB = 8, SEQ = 4096, DB = 32, DS = 32, PAST = 4096;
constexpr int MP = NB * SEQ, MS = DB * DS, M = MP + MS;
constexpr int DFF = 2816, NFF2 = 2 * DFF, NIN = 3584, HW = 512;
constexpr float EPS = 1e-6f;
constexpr int NPHASE = 8;
constexpr size_t OFF_KP = (size_t)M * DM, OFF_VP = OFF_KP + (size_t)MP * HW, OFF_SP = OFF_VP + (size_t)MP * HW, OFF_KS = OFF_SP + (size_t)NB * 4 * 16384,
                 OFF_VS = OFF_KS + (size_t)MS * HW, OFF_SS = OFF_VS + (size_t)MS * HW;
constexpr size_t MiB = 1u << 20;
constexpr size_t WS_CTL = 0, CTL_BYTES = 65536;
constexpr size_t WS_W1 = 1 * MiB, WS_W2 = 13 * MiB, WS_W3 = 19 * MiB, WS_W4 = 27 * MiB, WS_W5 = 30 * MiB, WS_W6 = 42 * MiB;
constexpr size_t WS_SSQA = 48 * MiB, WS_SSQB = 49 * MiB, WS_SSQC = 52 * MiB;
constexpr size_t WS_XB = 56 * MiB;
constexpr size_t WS_ACT = 124 * MiB;
constexpr size_t WS_Q = 308 * MiB, WS_K = 342 * MiB, WS_V = 376 * MiB, WS_HQ = 410 * MiB, WS_KIN = 444 * MiB, WS_HI = 478 * MiB, WS_HG = 512 * MiB;
constexpr size_t WS_LF = 546 * MiB;
constexpr size_t WS_MIX = 614 * MiB;
constexpr size_t WS_PART = 682 * MiB;
constexpr size_t WS_END = 728 * MiB;
static_assert(WS_V - WS_K == WS_K - WS_Q && WS_HQ - WS_V == WS_K - WS_Q && WS_KIN - WS_HQ == WS_K - WS_Q && WS_HI - WS_KIN == WS_K - WS_Q && WS_HG - WS_HI == WS_K - WS_Q, "fixed stride");
static_assert((size_t)NFF2 * DM * 2 <= 12 * MiB && (size_t)DM * DFF * 2 <= 6 * MiB && (size_t)NIN * DM * 2 <= 8 * MiB && (size_t)M * 16 * 4 <= 3 * MiB, "ws map");
static_assert((size_t)M * DM * 2 <= 68 * MiB && (size_t)M * DFF * 2 <= 184 * MiB && (size_t)M * HW * 2 <= 34 * MiB && (size_t)M * HW * 4 <= 68 * MiB, "ws map 2");

constexpr int LDS_BYTES = 147456;
constexpr int NWAVES = 8;

#define LAS __attribute__((address_space(3)))
typedef unsigned short bf16;
typedef unsigned char u8;
using pg8::f32x4; using pg8::u32x4; using pg8::bf16x8; using pg8::Unit;
typedef unsigned u32x2 __attribute__((ext_vector_type(2)));
#define MFMA16(a, b, c) __builtin_amdgcn_mfma_f32_16x16x32_bf16((a), (b), (c), 0, 0, 0)

typedef float f32x2_t __attribute__((ext_vector_type(2))); typedef __bf16 bf16x2_t __attribute__((ext_vector_type(2)));
__device__ __forceinline__ unsigned pkbf(float lo, float hi) { f32x2_t v = {lo, hi}; bf16x2_t b = __builtin_convertvector(v, bf16x2_t); return __builtin_bit_cast(unsigned, b); }
__device__ __forceinline__ u32x4 pack8(f32x4 a, f32x4 b) { u32x4 w; w.x = pkbf(a[0], a[1]); w.y = pkbf(a[2], a[3]); w.z = pkbf(b[0], b[1]); w.w = pkbf(b[2], b[3]); return w; }
__device__ __forceinline__ float bf2f(unsigned short v) { return __uint_as_float((unsigned)v << 16); }
__device__ __forceinline__ float fexp(float v) { return __builtin_amdgcn_exp2f(v * 1.44269504f); }
__device__ __forceinline__ float siluf(float v) { return v * __builtin_amdgcn_rcpf(1.f + fexp(-v)); }
__device__ __forceinline__ bf16x8 as_bf(u32x4 v) { return __builtin_bit_cast(bf16x8, v); }

template <int NP4> __device__ __forceinline__ void row_scales(const float* ssq, const Unit& u, int wr, int fr, float (&rs)[2][4]) {
#pragma unroll
    for (int ai = 0; ai < 2; ++ai)
#pragma unroll
        for (int m = 0; m < 4; ++m) {
            const int row = u.pm * 256 + ai * 128 + wr * 64 + m * 16 + fr; const f32x4* p = (const f32x4*)(ssq + (size_t)row * (4 * NP4)); float s = 0.f;
#pragma unroll
            for (int k = 0; k < NP4; ++k) { const f32x4 v = p[k]; s += (v[0] + v[1]) + (v[2] + v[3]); }
            rs[ai][m] = rsqrtf(s * (1.f / DM) + EPS);
        }
}
template <int NP4> struct EpiSwiglu {
    static constexpr bool PERM = true, AFTER_DRAIN = false;
    bf16* O; const float* ssq;
    __device__ __forceinline__ void operator()(const f32x4 (&acc)[2][2][4][2], const Unit& u, int wr, int wc, int fr, int fq) const {
        float rs[2][4]; row_scales<NP4>(ssq, u, wr, fr, rs);
        const int col0 = u.pn * 128 + wc * 32 + 8 * fq;
#pragma unroll
        for (int ai = 0; ai < 2; ++ai)
#pragma unroll
            for (int m = 0; m < 4; ++m) {
                const int row = u.pm * 256 + ai * 128 + wr * 64 + m * 16 + fr; const float s = rs[ai][m];
                f32x4 o[2];
#pragma unroll
                for (int n = 0; n < 2; ++n) { const f32x4 a = acc[ai][0][m][n] * s, b = acc[ai][1][m][n] * s;
#pragma unroll
                    for (int i = 0; i < 4; ++i) o[n][i] = siluf(a[i]) * b[i]; }
                *(u32x4*)(O + (size_t)row * DFF + col0) = pack8(o[0], o[1]);
            }
    }
};
template <bool RESB, bool WB, bool OUTF> struct EpiResid {
    static constexpr bool PERM = true, AFTER_DRAIN = false;
    const float* resid; float* out; bf16* xb; float* ssq; float alpha;
    __device__ __forceinline__ void operator()(const f32x4 (&acc)[2][2][4][2], const Unit& u, int wr, int wc, int fr, int fq) const {
        const int col0 = u.pn * 256 + wc * 32 + 8 * fq;
#pragma unroll
        for (int ai = 0; ai < 2; ++ai)
#pragma unroll
            for (int m = 0; m < 4; ++m) {
                const int row = u.pm * 256 + ai * 128 + wr * 64 + m * 16 + fr; float ss = 0.f;
#pragma unroll
                for (int bj = 0; bj < 2; ++bj) {
                    const size_t off = (size_t)row * DM + col0 + bj * 128;
                    f32x4 r0, r1;
                    if (RESB) { const u32x4 rb = *(const u32x4*)(xb + off);
                        r0 = (f32x4){__uint_as_float(rb.x << 16), __uint_as_float(rb.x & 0xffff0000u), __uint_as_float(rb.y << 16), __uint_as_float(rb.y & 0xffff0000u)};
                        r1 = (f32x4){__uint_as_float(rb.z << 16), __uint_as_float(rb.z & 0xffff0000u), __uint_as_float(rb.w << 16), __uint_as_float(rb.w & 0xffff0000u)}; }
                    else { r0 = *(const f32x4*)(resid + off); r1 = *(const f32x4*)(resid + off + 4); }
                    const f32x4 o0 = r0 + acc[ai][bj][m][0] * alpha, o1 = r1 + acc[ai][bj][m][1] * alpha;
                    if (OUTF) { *(f32x4*)(out + off) = o0; *(f32x4*)(out + off + 4) = o1; }
                    if (WB) { ss += (o0[0] * o0[0] + o0[1] * o0[1]) + (o0[2] * o0[2] + o0[3] * o0[3]) + (o1[0] * o1[0] + o1[1] * o1[1]) + (o1[2] * o1[2] + o1[3] * o1[3]);
                        *(u32x4*)(xb + off) = pack8(o0, o1); }
                }
                if (WB) { ss += __shfl_xor(ss, 16); ss += __shfl_xor(ss, 32); if (fq == 0) ssq[(size_t)row * 16 + u.pn * 4 + wc] = ss; }
            }
    }
};
constexpr int SPLIT_NS = DFF / 256;
struct SplitOrder {
    int G, c, ns;
    __device__ bool next(int i, Unit& u) const { const int L = i * G + c; if (L >= 16 * ns) return false; const int tile = L % 16, slc = L / 16; u.pm = tile >> 2; u.pn = tile & 3; u.ko = slc * 256 * 2; u.sl = slc; return true; }
    __device__ __forceinline__ void a_ready(const Unit&) const {}
    __device__ __forceinline__ void done(const Unit&) const {}
};
struct EpiPart {
    static constexpr bool PERM = true, AFTER_DRAIN = false;
    float* part;
    __device__ __forceinline__ void operator()(const f32x4 (&acc)[2][2][4][2], const Unit& u, int wr, int wc, int fr, int fq) const {
        const int col0 = u.pn * 256 + wc * 32 + 8 * fq; float* base = part + (size_t)u.sl * MS * DM;
#pragma unroll
        for (int ai = 0; ai < 2; ++ai)
#pragma unroll
            for (int m = 0; m < 4; ++m) { const int row = u.pm * 256 + ai * 128 + wr * 64 + m * 16 + fr;
#pragma unroll
                for (int bj = 0; bj < 2; ++bj) { float* p = base + (size_t)row * DM + col0 + bj * 128; *(f32x4*)p = acc[ai][bj][m][0]; *(f32x4*)(p + 4) = acc[ai][bj][m][1]; } }
    }
};
struct EpiProj {
    static constexpr bool PERM = true, AFTER_DRAIN = false;
    const float* ssq; bf16 *Qb, *Kb, *Vb, *HQ, *KIN, *HI, *HG; float* LF; float* dout; const float *qg, *kg, *lbl;
    __device__ __forceinline__ void operator()(const f32x4 (&acc)[2][2][4][2], const Unit& u, int wr, int wc, int fr, int fq) const {
        float rs[2][4]; row_scales<4>(ssq, u, wr, fr, rs);
        const int grp = u.pn >> 1, lc0 = (u.pn & 1) * 256 + wc * 64 + 8 * fq;
        const bool prompt = u.pm < (MP / 256);
        if (grp <= 1) {
            const float* gain = grp == 0 ? qg : kg; const float post = grp == 0 ? 0.125f : 1.f;
            f32x4 gv[2][2];
#pragma unroll
            for (int bj = 0; bj < 2; ++bj)
#pragma unroll
                for (int n = 0; n < 2; ++n) gv[bj][n] = *(const f32x4*)(gain + 32 * bj + 8 * fq + 4 * n) * post;
            float* fo = prompt ? dout + OFF_KP : dout + OFF_KS - (size_t)MP * HW;
#pragma unroll
            for (int ai = 0; ai < 2; ++ai)
#pragma unroll
                for (int m = 0; m < 4; ++m) {
                    const int row = u.pm * 256 + ai * 128 + wr * 64 + m * 16 + fr; const float s = rs[ai][m];
                    f32x4 v[2][2]; float ss = 0.f;
#pragma unroll
                    for (int bj = 0; bj < 2; ++bj)
#pragma unroll
                        for (int n = 0; n < 2; ++n) { v[bj][n] = acc[ai][bj][m][n] * s; const f32x4 t = v[bj][n]; ss += (t[0] * t[0] + t[1] * t[1]) + (t[2] * t[2] + t[3] * t[3]); }
                    ss += __shfl_xor(ss, 16); ss += __shfl_xor(ss, 32);
                    const float rn = rsqrtf(ss * (1.f / 64.f) + EPS);
#pragma unroll
                    for (int bj = 0; bj < 2; ++bj) {
                        const f32x4 o0 = v[bj][0] * rn * gv[bj][0], o1 = v[bj][1] * rn * gv[bj][1];
                        const size_t off = (size_t)row * HW + lc0 + 32 * bj;
                        if (grp == 0) *(u32x4*)(Qb + off) = pack8(o0, o1);
                        else { *(u32x4*)(Kb + off) = pack8(o0, o1); *(f32x4*)(fo + off) = o0; *(f32x4*)(fo + off + 4) = o1; }
                    }
                }
        } else if (grp == 4) {
            f32x4 lb[2][2];
#pragma unroll
            for (int bj = 0; bj < 2; ++bj)
#pragma unroll
                for (int n = 0; n < 2; ++n) { const int ch = lc0 + 32 * bj + 4 * n; const f32x4 l0 = *(const f32x4*)(lbl + ch), l1 = *(const f32x4*)(lbl + HW + ch);
#pragma unroll
                    for (int i = 0; i < 4; ++i) lb[bj][n][i] = 1.f / (1.f + __expf(l1[i] - l0[i])); }
#pragma unroll
            for (int ai = 0; ai < 2; ++ai)
#pragma unroll
                for (int m = 0; m < 4; ++m) {
                    const int row = u.pm * 256 + ai * 128 + wr * 64 + m * 16 + fr; const float s = rs[ai][m];
#pragma unroll
                    for (int bj = 0; bj < 2; ++bj) {
                        f32x4 lf[2], kn[2];
#pragma unroll
                        for (int n = 0; n < 2; ++n)
#pragma unroll
                            for (int i = 0; i < 4; ++i) { const float v = acc[ai][bj][m][n][i] * s, e = fexp(fminf(-v, 80.f)), sg = __builtin_amdgcn_rcpf(1.f + e), l = lb[bj][n][i];
                                lf[n][i] = 0.69314718f * __builtin_amdgcn_logf(l + (1.f - l) * sg); kn[n][i] = (1.f - l) * (e * sg); }
                        const size_t off = (size_t)row * HW + lc0 + 32 * bj;
                        *(f32x4*)(LF + off) = lf[0]; *(f32x4*)(LF + off + 4) = lf[1]; *(u32x4*)(KIN + off) = pack8(kn[0], kn[1]);
                    }
                }
        } else {
            bf16* ob = Qb + (size_t)grp * ((WS_K - WS_Q) / 2);
            const bool act = (grp == 3 || grp == 6);
            float* fo = prompt ? dout + OFF_VP : dout + OFF_VS - (size_t)MP * HW;
#pragma unroll
            for (int ai = 0; ai < 2; ++ai)
#pragma unroll
                for (int m = 0; m < 4; ++m) {
                    const int row = u.pm * 256 + ai * 128 + wr * 64 + m * 16 + fr; const float s = rs[ai][m];
#pragma unroll
                    for (int bj = 0; bj < 2; ++bj) {
                        f32x4 o0 = acc[ai][bj][m][0] * s, o1 = acc[ai][bj][m][1] * s;
                        if (act) {
#pragma unroll
                            for (int i = 0; i < 4; ++i) { o0[i] = siluf(o0[i]); o1[i] = siluf(o1[i]); } }
                        const size_t off = (size_t)row * HW + lc0 + 32 * bj;
                        *(u32x4*)(ob + off) = pack8(o0, o1);
                        if (grp == 2) { *(f32x4*)(fo + off) = o0; *(f32x4*)(fo + off + 4) = o1; }
                    }
                }
        }
    }
};

__device__ __forceinline__ float wave_sum(float v) {
#pragma unroll
    for (int o = 1; o < 64; o <<= 1) v += __shfl_xor(v, o);
    return v;
}
template <int MAP> __device__ __forceinline__ int src_col(int n) {
    if (MAP == 0) return n;
    if (MAP == 1) { const int pn = n >> 8, r = n & 255; return r < 128 ? pn * 128 + r : DFF + pn * 128 + (r - 128); }
    const int pn = n >> 8, r = n & 255, bj = r >> 7, wc = (r >> 5) & 3, j = r & 31; return pn * 256 + wc * 64 + bj * 32 + j;
}
template <int MAP> __device__ __forceinline__ void transpose_item(const float* W, int K, int N, bf16* WT, const float* kg, LAS float* scr, int item, int lane) {
    const int nblk = N / 32, kb = item / nblk, nb = item % nblk, k0 = 64 * kb, n0 = 32 * nb, sn0 = src_col<MAP>(n0);
    float wv[32];
#pragma unroll
    for (int i = 0; i < 32; ++i) { const int kk = 2 * i + (lane >> 5); wv[i] = W[(size_t)(k0 + kk) * N + sn0 + (lane & 31)]; }
#pragma unroll
    for (int i = 0; i < 32; ++i) { const int kk = 2 * i + (lane >> 5); float w = wv[i]; if (kg) w *= kg[k0 + kk]; scr[kk * 33 + (lane & 31)] = w; }
    asm volatile("s_waitcnt lgkmcnt(0)" ::: "memory");
    const int c = lane & 7;
#pragma unroll
    for (int j = 0; j < 4; ++j) { const int n = (lane >> 3) + 8 * j; const LAS float* s = scr + (8 * c) * 33 + n;
        u32x4 o; o.x = pkbf(s[0 * 33], s[1 * 33]); o.y = pkbf(s[2 * 33], s[3 * 33]); o.z = pkbf(s[4 * 33], s[5 * 33]); o.w = pkbf(s[6 * 33], s[7 * 33]);
        *(u32x4*)(WT + (size_t)(n0 + n) * K + k0 + 8 * c) = o; }
    asm volatile("s_waitcnt lgkmcnt(0)" ::: "memory");
}

typedef __attribute__((address_space(1))) unsigned gu32;
#define XB_TMO      128
#define XB_XCNT(j)  (256  + 64 * (j))
#define XB_XSUB(j)  (1280 + 64 * (j))
#define XB_XGEN(j)  (2304 + 64 * (j))
#define XB_TOP      3328
#define XB_TOPGEN   3392
#define XCD_BAR_WORDS 3456
#define XB_SPIN_CAP (1u << 18)

__device__ __forceinline__ unsigned xb_ld(unsigned* p)              { return __hip_atomic_load(p, __ATOMIC_RELAXED, __HIP_MEMORY_SCOPE_AGENT); }
__device__ __forceinline__ unsigned xb_add(unsigned* p, unsigned v) { return __hip_atomic_fetch_add(p, v, __ATOMIC_RELAXED, __HIP_MEMORY_SCOPE_AGENT); }
__device__ __forceinline__ unsigned xb_xcc_id() { return (unsigned)__builtin_amdgcn_s_getreg((3 << 11) | 20) & 0xFu; }
#define XB_SPIN(cond, bar) do { unsigned _sp = 0; while (cond) { __builtin_amdgcn_s_sleep(1); \
    if ((++_sp & 255u) == 0u) { if (xb_ld(&(bar)[XB_TMO])) break; if (_sp > XB_SPIN_CAP) { atomicAdd(&(bar)[XB_TMO], 1u); break; } } } } while (0)

struct XcdBarrier {
    unsigned* bar; unsigned x;
    volatile LAS unsigned* st;
};

__device__ __forceinline__ XcdBarrier xcd_barrier_post(unsigned* bar, volatile LAS unsigned* st, int wv) {
    XcdBarrier b; b.bar = bar; b.x = xb_xcc_id(); b.st = st;
    if (wv == 0 && lane_id() == 0) (void)xb_add(&bar[XB_XCNT(b.x)], 1u);
    return b;
}
__device__ __forceinline__ void xcd_barrier_complete(unsigned* bar, unsigned x, unsigned& nloc, unsigned& nx) {
    const unsigned G = gridDim.x * gridDim.y * gridDim.z;
    unsigned sum, cnt, mine, sp = 0u;
    for (;;) {
        sum = 0u; cnt = 0u; mine = 0u;
#pragma unroll
        for (unsigned j = 0; j < 16; ++j) { const unsigned c = xb_ld(&bar[XB_XCNT(j)]); sum += c; cnt += (c > 0u) ? 1u : 0u; mine = (j == x) ? c : mine; }
        if (sum == G) break;
        __builtin_amdgcn_s_sleep(1);
        if ((++sp & 255u) == 0u) { if (xb_ld(&bar[XB_TMO])) break; if (sp > XB_SPIN_CAP) { atomicAdd(&bar[XB_TMO], 1u); break; } }
    }
    nloc = mine > 0u ? mine : 1u; nx = cnt > 0u ? cnt : 1u;
}

__device__ __forceinline__ void xcd_barrier(const XcdBarrier& b, int wv) {
    asm volatile("s_waitcnt vmcnt(0)" ::: "memory");
    __syncthreads();
    if (wv == 0 && lane_id() == 0) {
        unsigned* bar = b.bar;
        __builtin_amdgcn_s_waitcnt(0);
        unsigned nloc = b.st[0], nx = b.st[1];
        if (nloc == 0u) { xcd_barrier_complete(bar, b.x, nloc, nx); b.st[0] = nloc; b.st[1] = nx; }
        const unsigned old = xb_add(&bar[XB_XSUB(b.x)], 1u);
        const unsigned gen = old / nloc;
        if (old + 1u == (gen + 1u) * nloc) {
            __builtin_amdgcn_fence(__ATOMIC_RELEASE, "agent");
            asm volatile("s_waitcnt vmcnt(0)" ::: "memory");
            const unsigned og = xb_add(&bar[XB_TOP], 1u);
            const unsigned tg = og / nx;
            if (og + 1u == (tg + 1u) * nx) xb_add(&bar[XB_TOPGEN], 1u);
            else XB_SPIN(xb_ld(&bar[XB_TOPGEN]) == tg, bar);
            __builtin_amdgcn_fence(__ATOMIC_ACQUIRE, "agent");
            xb_add(&bar[XB_XGEN(b.x)], 1u);
            asm volatile("s_waitcnt vmcnt(0)" ::: "memory");
        } else {
            XB_SPIN(xb_ld(&bar[XB_XGEN(b.x)]) == gen, bar);
            __builtin_amdgcn_fence(__ATOMIC_ACQUIRE, "agent");
            asm volatile("s_waitcnt vmcnt(0)" ::: "memory");
        }
    }
    __syncthreads();
}

struct Args {
    const float *xp, *xs, *ck, *cv, *st0, *g1, *w1, *w2, *gm, *win, *qg, *kg, *lbl, *og, *hgg, *wo, *g2, *w5, *w6;
    float* out; unsigned char* ws; int ph_lo, ph_hi;
};

struct ChunkRaw { u32x4 k[4]; u32x4 v[4]; };
__device__ __forceinline__ void load_chunk(ChunkRaw& r, int c, int ncache, const bf16* Kn, const bf16* Vn, const float* cK, const float* cV, int lane) {
    const int key = lane & 15, g = lane >> 4, vkey = lane >> 3, vds = lane & 7;
    if (32 * c >= ncache) {
        const int rel = 32 * c - ncache;
#pragma unroll
        for (int kt = 0; kt < 2; ++kt)
#pragma unroll
            for (int kk = 0; kk < 2; ++kk) r.k[kt * 2 + kk] = *(const u32x4*)(Kn + (size_t)(rel + 16 * kt + key) * HW + 32 * kk + 8 * g);
#pragma unroll
        for (int pi = 0; pi < 4; ++pi) r.v[pi] = *(const u32x4*)(Vn + (size_t)(rel + vkey + 8 * pi) * HW + 8 * vds);
    } else {
#pragma unroll
        for (int kt = 0; kt < 2; ++kt)
#pragma unroll
            for (int kk = 0; kk < 2; ++kk) { const float* p = cK + (size_t)(32 * c + 16 * kt + key) * HW + 32 * kk + 8 * g; r.k[kt * 2 + kk] = pack8(*(const f32x4*)p, *(const f32x4*)(p + 4)); }
#pragma unroll
        for (int pi = 0; pi < 4; ++pi) { const float* p = cV + (size_t)(32 * c + vkey + 8 * pi) * HW + 8 * vds; r.v[pi] = pack8(*(const f32x4*)p, *(const f32x4*)(p + 4)); }
    }
}
__device__ __forceinline__ void attn_unit(LAS u8* wl, const bf16* Q, const bf16* Kn, const bf16* Vn, const float* cK, const float* cV, int ncache, int qpos0, const float* ogain, bf16* out, int lane) {
    const int q = lane & 15, g = lane >> 4;
    bf16x8 qf[2];
#pragma unroll
    for (int kk = 0; kk < 2; ++kk) qf[kk] = as_bf(*(const u32x4*)(Q + (size_t)q * HW + 32 * kk + 8 * g));
    bf16x8 TA[2], ONES;
#pragma unroll
    for (int j = 0; j < 8; ++j) { const int keyp = j < 4 ? 4 * g + j : 12 + 4 * g + j; TA[0][j] = keyp > q ? (short)0x3F80 : (short)0; TA[1][j] = keyp > 16 + q ? (short)0x3F80 : (short)0; ONES[j] = (short)0x3F80; }
    f32x4 O[4];
#pragma unroll
    for (int dt = 0; dt < 4; ++dt) O[dt] = (f32x4){0.f, 0.f, 0.f, 0.f};
    float carry = 0.f;
    const int cstart = qpos0 >> 5, qpos = qpos0 + q;
#define ATT_CHUNK(R_, C_) do { \
_Pragma("unroll") \
        for (int pi = 0; pi < 4; ++pi) { LAS u8* p = wl + ((lane >> 3) + 8 * pi) * 136 + (lane & 7) * 16; *(LAS u32x2*)p = (u32x2){R_.v[pi].x, R_.v[pi].y}; *(LAS u32x2*)(p + 8) = (u32x2){R_.v[pi].z, R_.v[pi].w}; } \
        f32x4 st[2]; \
_Pragma("unroll") \
        for (int kt = 0; kt < 2; ++kt) { st[kt] = (f32x4){0.f, 0.f, 0.f, 0.f}; \
_Pragma("unroll") \
            for (int kk = 0; kk < 2; ++kk) st[kt] = MFMA16(as_bf(R_.k[kt * 2 + kk]), qf[kk], st[kt]); } \
        float ls[2][4], lk[2][4]; bool ok[2][4]; \
_Pragma("unroll") \
        for (int kt = 0; kt < 2; ++kt) \
_Pragma("unroll") \
            for (int i = 0; i < 4; ++i) { const float z = st[kt][i], L = -0.69314718f * __builtin_amdgcn_logf(1.f + fexp(-fabsf(z))); \
                ok[kt][i] = (32 * (C_) + 16 * kt + 4 * g + i) < qpos; \
                ls[kt][i] = z < 0.f ? z + L : L; lk[kt][i] = ok[kt][i] ? (z < 0.f ? L : L - z) : 0.f; } \
        u32x4 bhi, blo; \
        bhi.x = pkbf(lk[0][0], lk[0][1]); bhi.y = pkbf(lk[0][2], lk[0][3]); bhi.z = pkbf(lk[1][0], lk[1][1]); bhi.w = pkbf(lk[1][2], lk[1][3]); \
        blo.x = pkbf(lk[0][0] - __uint_as_float(bhi.x << 16), lk[0][1] - __uint_as_float(bhi.x & 0xffff0000u)); \
        blo.y = pkbf(lk[0][2] - __uint_as_float(bhi.y << 16), lk[0][3] - __uint_as_float(bhi.y & 0xffff0000u)); \
        blo.z = pkbf(lk[1][0] - __uint_as_float(bhi.z << 16), lk[1][1] - __uint_as_float(bhi.z & 0xffff0000u)); \
        blo.w = pkbf(lk[1][2] - __uint_as_float(bhi.w << 16), lk[1][3] - __uint_as_float(bhi.w & 0xffff0000u)); \
        f32x4 tail[2], tot; \
        const f32x4 z4 = (f32x4){0.f, 0.f, 0.f, 0.f}; \
_Pragma("unroll") \
        for (int kt = 0; kt < 2; ++kt) { tail[kt] = MFMA16(TA[kt], as_bf(bhi), z4); tail[kt] = MFMA16(TA[kt], as_bf(blo), tail[kt]); } \
        tot = MFMA16(ONES, as_bf(bhi), z4); tot = MFMA16(ONES, as_bf(blo), tot); \
        float w[2][4]; \
_Pragma("unroll") \
        for (int kt = 0; kt < 2; ++kt) \
_Pragma("unroll") \
            for (int i = 0; i < 4; ++i) w[kt][i] = ok[kt][i] ? fexp(ls[kt][i] + tail[kt][i] + carry) : 0.f; \
        carry += tot[0]; \
        u32x4 bw; bw.x = pkbf(w[0][0], w[0][1]); bw.y = pkbf(w[0][2], w[0][3]); bw.z = pkbf(w[1][0], w[1][1]); bw.w = pkbf(w[1][2], w[1][3]); \
        asm volatile("s_waitcnt lgkmcnt(0)" ::: "memory"); \
_Pragma("unroll") \
        for (int dt = 0; dt < 4; ++dt) { bf16x8 vf; \
_Pragma("unroll") \
            for (int j = 0; j < 8; ++j) { const int keyp = j < 4 ? 4 * g + j : 12 + 4 * g + j; vf[j] = (short)*(const LAS unsigned short*)(wl + keyp * 136 + (16 * dt + q) * 2); } \
            O[dt] = MFMA16(vf, as_bf(bw), O[dt]); } \
        asm volatile("s_waitcnt lgkmcnt(0)" ::: "memory"); \
    } while (0)
    ChunkRaw bufA, bufB; load_chunk(bufA, cstart, ncache, Kn, Vn, cK, cV, lane);
    for (int c = cstart;; c -= 2) {
        load_chunk(bufB, c > 0 ? c - 1 : 0, ncache, Kn, Vn, cK, cV, lane);
        ATT_CHUNK(bufA, c);
        if (c == 0 || __all(carry < -104.f)) break;
        load_chunk(bufA, c > 1 ? c - 2 : 0, ncache, Kn, Vn, cK, cV, lane);
        ATT_CHUNK(bufB, c - 1);
        if (c == 1 || __all(carry < -104.f)) break;
    }
#undef ATT_CHUNK
    float ss = 0.f;
#pragma unroll
    for (int dt = 0; dt < 4; ++dt) ss += (O[dt][0] * O[dt][0] + O[dt][1] * O[dt][1]) + (O[dt][2] * O[dt][2] + O[dt][3] * O[dt][3]);
    ss += __shfl_xor(ss, 16); ss += __shfl_xor(ss, 32);
    const float rn = rsqrtf(ss * (1.f / 64.f) + EPS);
#pragma unroll
    for (int dt = 0; dt < 4; ++dt) { const int d0 = 16 * dt + 4 * g; const f32x4 gn = *(const f32x4*)(ogain + d0), o = O[dt] * rn * gn;
        *(u32x2*)(out + (size_t)q * DM + d0) = (u32x2){pkbf(o[0], o[1]), pkbf(o[2], o[3])}; }
}

__device__ __forceinline__ void attn_unit2(LAS u8* wl, const bf16* Q, const bf16* Kn, const bf16* Vn, const float* cK, const float* cV, int ncache, int qpos0, const float* ogain, bf16* out, int lane) {
    const int q = lane & 15, g = lane >> 4;
    bf16x8 qf[2][2];
#pragma unroll
    for (int T = 0; T < 2; ++T)
#pragma unroll
        for (int kk = 0; kk < 2; ++kk) qf[T][kk] = as_bf(*(const u32x4*)(Q + (size_t)(16 * T + q) * HW + 32 * kk + 8 * g));
    bf16x8 TA[2], ONES;
#pragma unroll
    for (int j = 0; j < 8; ++j) { const int keyp = j < 4 ? 4 * g + j : 12 + 4 * g + j; TA[0][j] = keyp > q ? (short)0x3F80 : (short)0; TA[1][j] = keyp > 16 + q ? (short)0x3F80 : (short)0; ONES[j] = (short)0x3F80; }
    f32x4 O[2][4];
#pragma unroll
    for (int T = 0; T < 2; ++T)
#pragma unroll
        for (int dt = 0; dt < 4; ++dt) O[T][dt] = (f32x4){0.f, 0.f, 0.f, 0.f};
    float carry[2] = {0.f, 0.f};
    const int cstart = qpos0 >> 5;
#define ATT_CHUNK2(R_, C_) do { \
        _Pragma("unroll") for (int pi = 0; pi < 4; ++pi) { LAS u8* p = wl + ((lane >> 3) + 8 * pi) * 136 + (lane & 7) * 16; *(LAS u32x2*)p = (u32x2){R_.v[pi].x, R_.v[pi].y}; *(LAS u32x2*)(p + 8) = (u32x2){R_.v[pi].z, R_.v[pi].w}; } \
        asm volatile("s_waitcnt lgkmcnt(0)" ::: "memory"); \
        bf16x8 vf[4]; \
        _Pragma("unroll") for (int dt = 0; dt < 4; ++dt) \
            _Pragma("unroll") for (int j = 0; j < 8; ++j) { const int keyp = j < 4 ? 4 * g + j : 12 + 4 * g + j; vf[dt][j] = (short)*(const LAS unsigned short*)(wl + keyp * 136 + (16 * dt + q) * 2); } \
        _Pragma("unroll") for (int T = 0; T < 2; ++T) { \
            const int qpos = qpos0 + 16 * T + q; \
            f32x4 st[2]; \
            _Pragma("unroll") for (int kt = 0; kt < 2; ++kt) { st[kt] = (f32x4){0.f, 0.f, 0.f, 0.f}; \
                _Pragma("unroll") for (int kk = 0; kk < 2; ++kk) st[kt] = MFMA16(as_bf(R_.k[kt * 2 + kk]), qf[T][kk], st[kt]); } \
            float ls[2][4], lk[2][4]; bool ok[2][4]; \
            _Pragma("unroll") for (int kt = 0; kt < 2; ++kt) \
                _Pragma("unroll") for (int i = 0; i < 4; ++i) { const float z = st[kt][i], L = -0.69314718f * __builtin_amdgcn_logf(1.f + fexp(-fabsf(z))); \
                    ok[kt][i] = (32 * (C_) + 16 * kt + 4 * g + i) < qpos; \
                    ls[kt][i] = z < 0.f ? z + L : L; lk[kt][i] = ok[kt][i] ? (z < 0.f ? L : L - z) : 0.f; } \
            u32x4 bhi, blo; \
            bhi.x = pkbf(lk[0][0], lk[0][1]); bhi.y = pkbf(lk[0][2], lk[0][3]); bhi.z = pkbf(lk[1][0], lk[1][1]); bhi.w = pkbf(lk[1][2], lk[1][3]); \
            blo.x = pkbf(lk[0][0] - __uint_as_float(bhi.x << 16), lk[0][1] - __uint_as_float(bhi.x & 0xffff0000u)); \
            blo.y = pkbf(lk[0][2] - __uint_as_float(bhi.y << 16), lk[0][3] - __uint_as_float(bhi.y & 0xffff0000u)); \
            blo.z = pkbf(lk[1][0] - __uint_as_float(bhi.z << 16), lk[1][1] - __uint_as_float(bhi.z & 0xffff0000u)); \
            blo.w = pkbf(lk[1][2] - __uint_as_float(bhi.w << 16), lk[1][3] - __uint_as_float(bhi.w & 0xffff0000u)); \
            f32x4 tail[2], tot; const f32x4 z4 = (f32x4){0.f, 0.f, 0.f, 0.f}; \
            _Pragma("unroll") for (int kt = 0; kt < 2; ++kt) { tail[kt] = MFMA16(TA[kt], as_bf(bhi), z4); tail[kt] = MFMA16(TA[kt], as_bf(blo), tail[kt]); } \
            tot = MFMA16(ONES, as_bf(bhi), z4); tot = MFMA16(ONES, as_bf(blo), tot); \
            float w[2][4]; \
            _Pragma("unroll") for (int kt = 0; kt < 2; ++kt) \
                _Pragma("unroll") for (int i = 0; i < 4; ++i) w[kt][i] = ok[kt][i] ? fexp(ls[kt][i] + tail[kt][i] + carry[T]) : 0.f; \
            carry[T] += tot[0]; \
            u32x4 bw; bw.x = pkbf(w[0][0], w[0][1]); bw.y = pkbf(w[0][2], w[0][3]); bw.z = pkbf(w[1][0], w[1][1]); bw.w = pkbf(w[1][2], w[1][3]); \
            _Pragma("unroll") for (int dt = 0; dt < 4; ++dt) O[T][dt] = MFMA16(vf[dt], as_bf(bw), O[T][dt]); \
        } \
        asm volatile("" ::: "memory"); \
    } while (0)
    ChunkRaw bufA, bufB; load_chunk(bufA, cstart, ncache, Kn, Vn, cK, cV, lane);
    for (int c = cstart;; c -= 2) {
        load_chunk(bufB, c > 0 ? c - 1 : 0, ncache, Kn, Vn, cK, cV, lane);
        ATT_CHUNK2(bufA, c);
        if (c == 0 || __all(carry[0] < -104.f && carry[1] < -104.f)) break;
        load_chunk(bufA, c > 1 ? c - 2 : 0, ncache, Kn, Vn, cK, cV, lane);
        ATT_CHUNK2(bufB, c - 1);
        if (c == 1 || __all(carry[0] < -104.f && carry[1] < -104.f)) break;
    }
#undef ATT_CHUNK2
#pragma unroll
    for (int T = 0; T < 2; ++T) {
        float ss = 0.f;
#pragma unroll
        for (int dt = 0; dt < 4; ++dt) ss += (O[T][dt][0] * O[T][dt][0] + O[T][dt][1] * O[T][dt][1]) + (O[T][dt][2] * O[T][dt][2] + O[T][dt][3] * O[T][dt][3]);
        ss += __shfl_xor(ss, 16); ss += __shfl_xor(ss, 32);
        const float rn = rsqrtf(ss * (1.f / 64.f) + EPS);
#pragma unroll
        for (int dt = 0; dt < 4; ++dt) { const int d0 = 16 * dt + 4 * g; const f32x4 gn = *(const f32x4*)(ogain + d0), o = O[T][dt] * rn * gn;
            *(u32x2*)(out + (size_t)(16 * T + q) * DM + d0) = (u32x2){pkbf(o[0], o[1]), pkbf(o[2], o[3])}; }
    }
}

constexpr int HG_QD = 0, HG_KDA = 8704, HG_KDT = 17408, HG_VT = 27648, HG_OB = 37888, HG_SEG = 54784, HG_AL = 56832, HG_LDS = 57344;
constexpr int ATT_LDS0 = 65536, ATT_WL = 4352;
template <bool SEG>
__device__ __forceinline__ void hgrn_unit(LAS u8* L, int row0, int nchunks, int h, const float* S0, float* Sout, const bf16* HQ, const bf16* KIN, const float* LF, const bf16* HI, const bf16* HG,
                                          const float* ogain, bf16* MIX, float* OLOC, bf16* QDG, float* DSEG, int tid) {
    const int lane = tid & 63, w = __builtin_amdgcn_readfirstlane(tid >> 6), q16 = lane & 15, g = lane >> 4;
    const int c = tid & 127, sg = tid >> 7, nt = tid >> 4, nvs = (tid & 15) * 8;
    f32x4 S[8];
#pragma unroll
    for (int ct = 0; ct < 8; ++ct)
#pragma unroll
        for (int i = 0; i < 4; ++i) S[ct][i] = S0 ? S0[(size_t)(16 * ct + 4 * g + i) * 128 + 16 * w + q16] : 0.f;
    float lf[8]; unsigned short qv[8], kv[8], vv[8]; u32x4 gt = (u32x4){0u, 0u, 0u, 0u}; float bseg = 0.f;
#define HG_LOAD(n) do { const size_t base_ = (size_t)(row0 + 32 * (n) + 8 * sg) * HW + 128 * h + c; \
        _Pragma("unroll") for (int i = 0; i < 8; ++i) { lf[i] = LF[base_ + (size_t)i * HW]; qv[i] = HQ[base_ + (size_t)i * HW]; kv[i] = KIN[base_ + (size_t)i * HW]; vv[i] = HI[base_ + (size_t)i * HW]; } \
        if (!SEG) gt = *(const u32x4*)(HG + (size_t)(row0 + 32 * (n) + nt) * HW + 128 * h + nvs); } while (0)
    HG_LOAD(0);
    f32x4 g0 = *(const f32x4*)(ogain + nvs), g1 = *(const f32x4*)(ogain + nvs + 4);
    asm volatile("s_waitcnt vmcnt(0)" ::: "memory");
    asm volatile("" : "+v"(g0), "+v"(g1));
#pragma unroll
    for (int ct = 0; ct < 8; ++ct) asm volatile("" : "+v"(S[ct]));
    for (int n = 0; n < nchunks; ++n) {
        float a[8]; float run = 0.f;
#pragma unroll
        for (int i = 0; i < 8; ++i) { run += lf[i]; a[i] = run; }
        ((LAS float*)(L + HG_SEG))[sg * 128 + c] = run;
        __syncthreads();
        float off = 0.f, tot = 0.f;
#pragma unroll
        for (int s = 0; s < 4; ++s) { const float v = ((const LAS float*)(L + HG_SEG))[s * 128 + c]; tot += v; off += (s < sg) ? v : 0.f; }
        float kds[8];
#pragma unroll
        for (int i = 0; i < 8; ++i) { const float ai = a[i] + off, qf = bf2f(qv[i]), kf = bf2f(kv[i]); const int t = 8 * sg + i;
            *(LAS unsigned short*)(L + HG_QD + t * 272 + c * 2) = (unsigned short)(pkbf(qf * __expf(ai), 0.f) & 0xffffu);
            *(LAS unsigned short*)(L + HG_KDA + t * 272 + c * 2) = (unsigned short)(pkbf(kf * __expf(fminf(-ai, 80.f)), 0.f) & 0xffffu);
            if (SEG) QDG[(size_t)(row0 + 32 * n + t) * HW + 128 * h + c] = (unsigned short)(pkbf(qf * __expf(ai + bseg), 0.f) & 0xffffu);
            kds[i] = kf * __expf(tot - ai); }
        if (SEG) bseg += tot;
        { u32x4 o; o.x = pkbf(kds[0], kds[1]); o.y = pkbf(kds[2], kds[3]); o.z = pkbf(kds[4], kds[5]); o.w = pkbf(kds[6], kds[7]); *(LAS u32x4*)(L + HG_KDT + c * 80 + sg * 16) = o;
          u32x4 v; v.x = (unsigned)vv[0] | ((unsigned)vv[1] << 16); v.y = (unsigned)vv[2] | ((unsigned)vv[3] << 16); v.z = (unsigned)vv[4] | ((unsigned)vv[5] << 16); v.w = (unsigned)vv[6] | ((unsigned)vv[7] << 16);
          *(LAS u32x4*)(L + HG_VT + c * 80 + sg * 16) = v; }
        if (sg == 3) ((LAS float*)(L + HG_AL))[c] = tot;
        const u32x4 gcur = gt;
        if (n + 1 < nchunks) HG_LOAD(n + 1);
        __syncthreads();
        f32x4 at00 = (f32x4){0.f, 0.f, 0.f, 0.f}, at01 = at00, at11 = at00;
#pragma unroll
        for (int kk = 0; kk < 4; ++kk) {
            const bf16x8 ka0 = *(const LAS bf16x8*)(L + HG_KDA + q16 * 272 + kk * 64 + g * 16), ka1 = *(const LAS bf16x8*)(L + HG_KDA + (16 + q16) * 272 + kk * 64 + g * 16);
            const bf16x8 qb0 = *(const LAS bf16x8*)(L + HG_QD + q16 * 272 + kk * 64 + g * 16), qb1 = *(const LAS bf16x8*)(L + HG_QD + (16 + q16) * 272 + kk * 64 + g * 16);
            at00 = MFMA16(ka0, qb0, at00); at01 = MFMA16(ka0, qb1, at01); at11 = MFMA16(ka1, qb1, at11);
        }
#pragma unroll
        for (int i = 0; i < 4; ++i) { const bool keep = (4 * g + i) <= q16; at00[i] = keep ? at00[i] : 0.f; at11[i] = keep ? at11[i] : 0.f; }
        u32x4 b0, b1; b0.x = pkbf(at00[0], at00[1]); b0.y = pkbf(at00[2], at00[3]); b0.z = 0u; b0.w = 0u;
        b1.x = pkbf(at01[0], at01[1]); b1.y = pkbf(at01[2], at01[3]); b1.z = pkbf(at11[0], at11[1]); b1.w = pkbf(at11[2], at11[3]);
        f32x4 o0 = (f32x4){0.f, 0.f, 0.f, 0.f}, o1 = o0;
#pragma unroll
        for (int ks = 0; ks < 4; ++ks) {
            const bf16x8 sa = as_bf(pack8(S[2 * ks], S[2 * ks + 1]));
            const u32x2 l0 = *(const LAS u32x2*)(L + HG_QD + q16 * 272 + (32 * ks + 4 * g) * 2), h0 = *(const LAS u32x2*)(L + HG_QD + q16 * 272 + (32 * ks + 16 + 4 * g) * 2);
            const u32x2 l1 = *(const LAS u32x2*)(L + HG_QD + (16 + q16) * 272 + (32 * ks + 4 * g) * 2), h1 = *(const LAS u32x2*)(L + HG_QD + (16 + q16) * 272 + (32 * ks + 16 + 4 * g) * 2);
            o0 = MFMA16(sa, as_bf((u32x4){l0.x, l0.y, h0.x, h0.y}), o0); o1 = MFMA16(sa, as_bf((u32x4){l1.x, l1.y, h1.x, h1.y}), o1);
        }
        { const u32x2 vl = *(const LAS u32x2*)(L + HG_VT + (16 * w + q16) * 80 + (4 * g) * 2), vh = *(const LAS u32x2*)(L + HG_VT + (16 * w + q16) * 80 + (16 + 4 * g) * 2);
          const bf16x8 va = as_bf((u32x4){vl.x, vl.y, vh.x, vh.y});
          o0 = MFMA16(va, as_bf(b0), o0); o1 = MFMA16(va, as_bf(b1), o1); }
        if (SEG) {
            float* op = OLOC + (size_t)(row0 + 32 * n + q16) * HW + 128 * h + 16 * w + 4 * g; *(f32x4*)op = o0; *(f32x4*)(op + (size_t)16 * HW) = o1;
        } else { *(LAS f32x4*)(L + HG_OB + q16 * 528 + (16 * w + 4 * g) * 4) = o0; *(LAS f32x4*)(L + HG_OB + (16 + q16) * 528 + (16 * w + 4 * g) * 4) = o1; }
        { const bf16x8 vb = *(const LAS bf16x8*)(L + HG_VT + (16 * w + q16) * 80 + g * 16);
#pragma unroll
          for (int ct = 0; ct < 8; ++ct) { const f32x4 al = *(const LAS f32x4*)(L + HG_AL + (16 * ct + 4 * g) * 4);
#pragma unroll
              for (int i = 0; i < 4; ++i) S[ct][i] *= __expf(al[i]);
              const bf16x8 ka = *(const LAS bf16x8*)(L + HG_KDT + (16 * ct + q16) * 80 + g * 16);
              S[ct] = MFMA16(ka, vb, S[ct]); } }
        if (!SEG) {
        __syncthreads();
        { const f32x4 x0 = *(const LAS f32x4*)(L + HG_OB + nt * 528 + nvs * 4), x1 = *(const LAS f32x4*)(L + HG_OB + nt * 528 + nvs * 4 + 16);
          {
          float ss = (x0[0] * x0[0] + x0[1] * x0[1]) + (x0[2] * x0[2] + x0[3] * x0[3]) + (x1[0] * x1[0] + x1[1] * x1[1]) + (x1[2] * x1[2] + x1[3] * x1[3]);
          ss += __shfl_xor(ss, 1); ss += __shfl_xor(ss, 2); ss += __shfl_xor(ss, 4); ss += __shfl_xor(ss, 8);
          const float rn = rsqrtf(ss * (1.f / 128.f) + EPS);
          f32x4 y0 = x0 * rn * g0, y1 = x1 * rn * g1;
          y0[0] *= __uint_as_float(gcur.x << 16); y0[1] *= __uint_as_float(gcur.x & 0xffff0000u); y0[2] *= __uint_as_float(gcur.y << 16); y0[3] *= __uint_as_float(gcur.y & 0xffff0000u);
          y1[0] *= __uint_as_float(gcur.z << 16); y1[1] *= __uint_as_float(gcur.z & 0xffff0000u); y1[2] *= __uint_as_float(gcur.w << 16); y1[3] *= __uint_as_float(gcur.w & 0xffff0000u);
          *(u32x4*)(MIX + (size_t)(row0 + 32 * n + nt) * DM + HW + 128 * h + nvs) = pack8(y0, y1); } }
        }
    }
#undef HG_LOAD
#pragma unroll
    for (int ct = 0; ct < 8; ++ct)
#pragma unroll
        for (int i = 0; i < 4; ++i) Sout[(size_t)(16 * ct + 4 * g + i) * 128 + 16 * w + q16] = S[ct][i];
    if (SEG && sg == 0) DSEG[c] = bseg;
    __syncthreads();
}

__device__ __forceinline__ void hgrn_fix(LAS u8* L, int row0, int j, int h, const float* SLOC, const float* DSEG, float* Sfin, const float* OLOC, const bf16* QDG, const bf16* HG, const float* ogain, bf16* MIX, int tid) {
    const int lane = tid & 63, w = __builtin_amdgcn_readfirstlane(tid >> 6), q16 = lane & 15, g = lane >> 4, nt = tid >> 4, nvs = (tid & 15) * 8;
    f32x4 S[8];
#pragma unroll
    for (int ct = 0; ct < 8; ++ct) S[ct] = (f32x4){0.f, 0.f, 0.f, 0.f};
    for (int i = 0; i < j; ++i) {
        const float* sl = SLOC + (size_t)i * 16384 + 16 * w + q16; const float* ds = DSEG + (size_t)i * 128;
#pragma unroll
        for (int ct = 0; ct < 8; ++ct) { const f32x4 d = *(const f32x4*)(ds + 16 * ct + 4 * g);
#pragma unroll
            for (int e = 0; e < 4; ++e) S[ct][e] = S[ct][e] * __expf(d[e]) + sl[(size_t)(16 * ct + 4 * g + e) * 128]; }
    }
    bf16x8 sa[4];
#pragma unroll
    for (int ks = 0; ks < 4; ++ks) sa[ks] = as_bf(pack8(S[2 * ks], S[2 * ks + 1]));
    if (j == 7) {
        const float* sl = SLOC + (size_t)7 * 16384 + 16 * w + q16; const float* ds = DSEG + (size_t)7 * 128;
#pragma unroll
        for (int ct = 0; ct < 8; ++ct) { const f32x4 d = *(const f32x4*)(ds + 16 * ct + 4 * g);
#pragma unroll
            for (int e = 0; e < 4; ++e) Sfin[(size_t)(16 * ct + 4 * g + e) * 128 + 16 * w + q16] = S[ct][e] * __expf(d[e]) + sl[(size_t)(16 * ct + 4 * g + e) * 128]; }
    }
    const f32x4 g0 = *(const f32x4*)(ogain + nvs), g1 = *(const f32x4*)(ogain + nvs + 4);
    f32x4 po0[2], po1[2]; u32x4 pg[2]; u32x2 pq[2][16];
#define FIX_LOAD(n, K) do { const int r_ = row0 + 512 * j + 32 * (n); const size_t c0_ = (size_t)(r_ + q16) * HW + 128 * h, c1_ = (size_t)(r_ + 16 + q16) * HW + 128 * h; \
        po0[K] = *(const f32x4*)(OLOC + c0_ + 16 * w + 4 * g); po1[K] = *(const f32x4*)(OLOC + c1_ + 16 * w + 4 * g); pg[K] = *(const u32x4*)(HG + (size_t)(r_ + nt) * HW + 128 * h + nvs); \
        if (j > 0) { _Pragma("unroll") for (int ks = 0; ks < 4; ++ks) { pq[K][4 * ks + 0] = *(const u32x2*)(QDG + c0_ + 32 * ks + 4 * g); pq[K][4 * ks + 1] = *(const u32x2*)(QDG + c0_ + 32 * ks + 16 + 4 * g); \
            pq[K][4 * ks + 2] = *(const u32x2*)(QDG + c1_ + 32 * ks + 4 * g); pq[K][4 * ks + 3] = *(const u32x2*)(QDG + c1_ + 32 * ks + 16 + 4 * g); } } } while (0)
    FIX_LOAD(0, 0); FIX_LOAD(1, 1);
    for (int n2 = 0; n2 < 8; ++n2) {
        f32x4 o0[2], o1[2]; u32x4 gc[2];
#pragma unroll
        for (int K = 0; K < 2; ++K) { o0[K] = po0[K]; o1[K] = po1[K]; gc[K] = pg[K];
            if (j > 0) {
#pragma unroll
                for (int ks = 0; ks < 4; ++ks) {
                    o0[K] = MFMA16(sa[ks], as_bf((u32x4){pq[K][4 * ks + 0].x, pq[K][4 * ks + 0].y, pq[K][4 * ks + 1].x, pq[K][4 * ks + 1].y}), o0[K]);
                    o1[K] = MFMA16(sa[ks], as_bf((u32x4){pq[K][4 * ks + 2].x, pq[K][4 * ks + 2].y, pq[K][4 * ks + 3].x, pq[K][4 * ks + 3].y}), o1[K]);
                }
            } }
        if (n2 + 1 < 8) { FIX_LOAD(2 * n2 + 2, 0); FIX_LOAD(2 * n2 + 3, 1); }
#pragma unroll
        for (int K = 0; K < 2; ++K) { *(LAS f32x4*)(L + HG_OB + (32 * K + q16) * 528 + (16 * w + 4 * g) * 4) = o0[K]; *(LAS f32x4*)(L + HG_OB + (32 * K + 16 + q16) * 528 + (16 * w + 4 * g) * 4) = o1[K]; }
        __syncthreads();
#pragma unroll
        for (int K = 0; K < 2; ++K) {
          const int r = row0 + 512 * j + 32 * (2 * n2 + K); const u32x4 gcur = gc[K];
          const f32x4 x0 = *(const LAS f32x4*)(L + HG_OB + (32 * K + nt) * 528 + nvs * 4), x1 = *(const LAS f32x4*)(L + HG_OB + (32 * K + nt) * 528 + nvs * 4 + 16);
          float ss = (x0[0] * x0[0] + x0[1] * x0[1]) + (x0[2] * x0[2] + x0[3] * x0[3]) + (x1[0] * x1[0] + x1[1] * x1[1]) + (x1[2] * x1[2] + x1[3] * x1[3]);
          ss += __shfl_xor(ss, 1); ss += __shfl_xor(ss, 2); ss += __shfl_xor(ss, 4); ss += __shfl_xor(ss, 8);
          const float rn = rsqrtf(ss * (1.f / 128.f) + EPS);
          f32x4 y0 = x0 * rn * g0, y1 = x1 * rn * g1;
          y0[0] *= __uint_as_float(gcur.x << 16); y0[1] *= __uint_as_float(gcur.x & 0xffff0000u); y0[2] *= __uint_as_float(gcur.y << 16); y0[3] *= __uint_as_float(gcur.y & 0xffff0000u);
          y1[0] *= __uint_as_float(gcur.z << 16); y1[1] *= __uint_as_float(gcur.z & 0xffff0000u); y1[2] *= __uint_as_float(gcur.w << 16); y1[3] *= __uint_as_float(gcur.w & 0xffff0000u);
          *(u32x4*)(MIX + (size_t)(r + nt) * DM + HW + 128 * h + nvs) = pack8(y0, y1); }
        __syncthreads();
    }
#undef FIX_LOAD
}

__global__ void __launch_bounds__(NWAVES * 64, 2) mk_fwd(Args A) {
    extern __shared__ __attribute__((aligned(16))) unsigned char lds[];
    LAS u8* L = (LAS u8*)lds;
    const int wave = __builtin_amdgcn_readfirstlane((int)threadIdx.x >> 6);
#define tid (wave * 64 + lane_id())
#define lane lane_id()
    const int G = gridDim.x, bid = blockIdx.x;
    unsigned char* ws = A.ws;
    bf16 *W1 = (bf16*)(ws + WS_W1), *W2 = (bf16*)(ws + WS_W2), *W3 = (bf16*)(ws + WS_W3), *W4 = (bf16*)(ws + WS_W4), *W5 = (bf16*)(ws + WS_W5), *W6 = (bf16*)(ws + WS_W6);
    float *SSQA = (float*)(ws + WS_SSQA), *SSQB = (float*)(ws + WS_SSQB), *SSQC = (float*)(ws + WS_SSQC);
    bf16 *XB = (bf16*)(ws + WS_XB), *ACT = (bf16*)(ws + WS_ACT), *Qb = (bf16*)(ws + WS_Q), *Kb = (bf16*)(ws + WS_K), *Vb = (bf16*)(ws + WS_V), *HQ = (bf16*)(ws + WS_HQ),
         *KIN = (bf16*)(ws + WS_KIN), *HI = (bf16*)(ws + WS_HI), *HG = (bf16*)(ws + WS_HG), *MIX = (bf16*)(ws + WS_MIX);
    float* LF = (float*)(ws + WS_LF); float* PART = (float*)(ws + WS_PART);
    float *OLOC = (float*)(ws + WS_ACT), *SLOC = (float*)(ws + WS_ACT + 110 * MiB), *DSEG = (float*)(ws + WS_ACT + 130 * MiB); bf16* QDG = (bf16*)(ws + WS_ACT + 70 * MiB);
    unsigned* ctl = (unsigned*)(ws + WS_CTL);
    const int lo = A.ph_lo, hi = A.ph_hi;
    volatile LAS unsigned* MISC = (volatile LAS unsigned*)(L + LDS_BYTES - 256);
    if (tid < 64) MISC[tid] = 0u;
    __syncthreads();
    XcdBarrier bar; bar.bar = ctl + 4096; bar.x = 0; bar.st = nullptr;
    if (hi - lo > 1) bar = xcd_barrier_post(ctl + 4096, MISC + 8, wave);
#define IN(k) (lo <= (k) && (k) < hi)
#define SEAM(k) do { if (IN(k) && IN((k) + 1)) { if ((k) == 0) cg::this_grid().sync(); xcd_barrier(bar, wave); } } while (0)

    if (IN(0)) {
        if (bid == 0 && tid == 0) __hip_atomic_store(ctl, 0u, __ATOMIC_RELAXED, __HIP_MEMORY_SCOPE_AGENT);
        LAS float* scr = (LAS float*)(L + wave * 16384);
        const int gw = bid * NWAVES + wave, NGW = G * NWAVES;
        constexpr int I1 = (DM / 64) * (NFF2 / 32), I2 = (DFF / 64) * (DM / 32), I3 = (DM / 64) * (NIN / 32), I4 = (DM / 64) * (DM / 32);
        constexpr int NITEMS = 2 * I1 + 2 * I2 + I3 + I4;
        for (int pass_ = 0; pass_ < 2; ++pass_) {
          if (((wave & 1) == 0) == (pass_ == 0)) {
            for (int it = gw; it < NITEMS; it += NGW) {
                int r = it;
                if (r < I1) { transpose_item<1>(A.w1, DM, NFF2, W1, A.g1, scr, r, lane); continue; } r -= I1;
                if (r < I1) { transpose_item<1>(A.w5, DM, NFF2, W5, A.g2, scr, r, lane); continue; } r -= I1;
                if (r < I2) { transpose_item<0>(A.w2, DFF, DM, W2, nullptr, scr, r, lane); continue; } r -= I2;
                if (r < I2) { transpose_item<0>(A.w6, DFF, DM, W6, nullptr, scr, r, lane); continue; } r -= I2;
                if (r < I3) { transpose_item<2>(A.win, DM, NIN, W3, A.gm, scr, r, lane); continue; } r -= I3;
                transpose_item<0>(A.wo, DM, DM, W4, nullptr, scr, r, lane);
            }
          } else {
            for (int m0 = gw; m0 < M; m0 += 2 * NGW) {
                const int m1 = m0 + NGW; const bool has1 = m1 < M;
                const float* xr0 = m0 < MP ? A.xp + (size_t)m0 * DM : A.xs + (size_t)(m0 - MP) * DM;
                const float* xr1 = has1 ? (m1 < MP ? A.xp + (size_t)m1 * DM : A.xs + (size_t)(m1 - MP) * DM) : xr0;
                const int ln = lane; f32x4 v0[4], v1[4]; float s0 = 0.f, s1 = 0.f;
    #pragma unroll
                for (int j = 0; j < 4; ++j) { v0[j] = ((const f32x4*)xr0)[ln + 64 * j]; v1[j] = ((const f32x4*)xr1)[ln + 64 * j]; }
    #pragma unroll
                for (int j = 0; j < 4; ++j) { s0 += (v0[j][0] * v0[j][0] + v0[j][1] * v0[j][1]) + (v0[j][2] * v0[j][2] + v0[j][3] * v0[j][3]); s1 += (v1[j][0] * v1[j][0] + v1[j][1] * v1[j][1]) + (v1[j][2] * v1[j][2] + v1[j][3] * v1[j][3]); }
                s0 = wave_sum(s0); s1 = wave_sum(s1);
                u32x2* o0 = (u32x2*)(XB + (size_t)m0 * DM) + ln;
    #pragma unroll
                for (int j = 0; j < 4; ++j) o0[64 * j] = (u32x2){pkbf(v0[j][0], v0[j][1]), pkbf(v0[j][2], v0[j][3])};
                if (ln == 0) *(f32x4*)(SSQA + (size_t)m0 * 4) = (f32x4){s0, 0.f, 0.f, 0.f};
                if (has1) { u32x2* o1 = (u32x2*)(XB + (size_t)m1 * DM) + ln;
    #pragma unroll
                    for (int j = 0; j < 4; ++j) o1[64 * j] = (u32x2){pkbf(v1[j][0], v1[j][1]), pkbf(v1[j][2], v1[j][3])};
                    if (ln == 0) *(f32x4*)(SSQA + (size_t)m1 * 4) = (f32x4){s1, 0.f, 0.f, 0.f}; }
            }
          }
        }
        __syncthreads();
    }
    SEAM(0);
    if (IN(1)) {
        pg8::Gemm g{XB, W1, M, NFF2, DM, DM / 64}; pg8::StaticOrder S; S.init(M, NFF2, G, bid);
        EpiSwiglu<1> E{ACT, SSQA};
        pg8::gemm_phase<EpiSwiglu<1>, pg8::StaticOrder, true, true>(L, g, S, E, wave);
    }
    SEAM(1);
    if (IN(2)) {
        { pg8::Gemm g{ACT, W2, MP, DM, DFF, DFF / 64}; pg8::StaticOrder S; S.init(MP, DM, G, bid);
          EpiResid<true, true, false> E{nullptr, nullptr, XB, SSQB, 0.5f};
          pg8::gemm_phase<EpiResid<true, true, false>, pg8::StaticOrder, true, true>(L, g, S, E, wave); }
        { pg8::Gemm g{ACT + (size_t)MP * DFF, W2, MS, DM, DFF, 4}; SplitOrder S{G, bid, SPLIT_NS}; EpiPart E{PART};
          pg8::gemm_phase<EpiPart, SplitOrder, true, true>(L, g, S, E, wave); }
    }
    SEAM(2);
    if (IN(3)) {
        {
            const int gw = bid * NWAVES + wave, NGW = G * NWAVES;
            for (int r = gw; r < MS; r += NGW) {
                const f32x4* xr = (const f32x4*)(A.xs + (size_t)r * DM) + lane; f32x4 acc4[4];
#pragma unroll
                for (int j = 0; j < 4; ++j) acc4[j] = (f32x4){0.f, 0.f, 0.f, 0.f};
                for (int sl = 0; sl < SPLIT_NS; ++sl) { const f32x4* pr = (const f32x4*)(PART + ((size_t)sl * MS + r) * DM) + lane;
#pragma unroll
                    for (int j = 0; j < 4; ++j) acc4[j] += pr[64 * j]; }
                float ssum = 0.f; f32x4 v[4];
#pragma unroll
                for (int j = 0; j < 4; ++j) { v[j] = xr[64 * j] + acc4[j] * 0.5f; ssum += (v[j][0] * v[j][0] + v[j][1] * v[j][1]) + (v[j][2] * v[j][2] + v[j][3] * v[j][3]); }
                ssum = wave_sum(ssum);
                u32x2* o8 = (u32x2*)(XB + (size_t)(MP + r) * DM) + lane;
#pragma unroll
                for (int j = 0; j < 4; ++j) o8[64 * j] = (u32x2){pkbf(v[j][0], v[j][1]), pkbf(v[j][2], v[j][3])};
                if (lane < 4) *(f32x4*)(SSQB + (size_t)(MP + r) * 16 + 4 * lane) = (f32x4){lane == 0 ? ssum : 0.f, 0.f, 0.f, 0.f};
            }
            xcd_barrier(bar, wave);
        }
        pg8::Gemm g{XB, W3, M, NIN, DM, DM / 64}; pg8::StaticOrder S; S.init(M, NIN, G, bid);
        EpiProj E{SSQB, Qb, Kb, Vb, HQ, KIN, HI, HG, LF, A.out, A.qg, A.kg, A.lbl};
        pg8::gemm_phase<EpiProj, pg8::StaticOrder, true, true>(L, g, S, E, wave);
    }
    SEAM(3);
    if (IN(4)) {
        __syncthreads();
        for (int u = bid; u < 256; u += G) {
            const int ch = u >> 3, j = u & 7, b = ch >> 2, h = ch & 3;
            hgrn_unit<true>(L, b * SEQ + 512 * j, 16, h, nullptr, SLOC + (size_t)u * 16384, HQ, KIN, LF, HI, HG, A.hgg, MIX, OLOC, QDG, DSEG + (size_t)u * 128, tid);
        }
        xcd_barrier(bar, wave);
        for (int u = bid; u < 256; u += G) {
            const int ch = u >> 3, j = u & 7, b = ch >> 2, h = ch & 3;
            hgrn_fix(L, b * SEQ, j, h, SLOC + (size_t)ch * 8 * 16384, DSEG + (size_t)ch * 8 * 128, A.out + OFF_SP + (size_t)ch * 16384, OLOC, QDG, HG, A.hgg, MIX, tid);
        }
        const bool g256 = (G == 256); const int jb = bid & 7;
        for (int v = g256 ? ((jb >= 3 && jb <= 6) ? (jb - 3) * 32 + (bid >> 3) : 128) : bid; v < 128; v += G) { const int b = v >> 2, h = v & 3;
            hgrn_unit<false>(L, MP + b * DS, 1, h, A.st0 + (size_t)v * 16384, A.out + OFF_SS + (size_t)v * 16384, HQ, KIN, LF, HI, HG, A.hgg, MIX, nullptr, nullptr, nullptr, tid); }
        LAS u8* wl = L + ATT_LDS0 + wave * ATT_WL;
        constexpr int NS = DB * 8, NP = NB * 8 * (SEQ / 32);
        const int pb = g256 ? ((jb << 5) | (bid >> 3)) : bid;
        for (unsigned it_ = 0;; ++it_) {
            const unsigned id = (unsigned)(pb * NWAVES + wave) + it_ * (unsigned)(G * NWAVES);
            if (id >= (unsigned)(NS + NP)) break;
            const unsigned sid = id - 256u;
            if (sid < (unsigned)NS) { const int b = sid >> 3, h = sid & 7; const int r0 = MP + b * DS;
                attn_unit2(wl, Qb + (size_t)r0 * HW + 64 * h, Kb + (size_t)r0 * HW + 64 * h, Vb + (size_t)r0 * HW + 64 * h, A.ck + (size_t)b * PAST * HW + 64 * h, A.cv + (size_t)b * PAST * HW + 64 * h,
                           PAST, PAST, A.og, MIX + (size_t)r0 * DM + 64 * h, lane); }
            else { const int v = id < 256u ? (int)id : (int)id - NS, bh = v >> 7, qt = v & 127, b = bh >> 3, h = bh & 7; const int r0 = b * SEQ;
                attn_unit2(wl, Qb + (size_t)(r0 + 32 * qt) * HW + 64 * h, Kb + (size_t)r0 * HW + 64 * h, Vb + (size_t)r0 * HW + 64 * h, nullptr, nullptr, 0, 32 * qt, A.og, MIX + (size_t)(r0 + 32 * qt) * DM + 64 * h, lane); }
        }
        __syncthreads();
    }
    SEAM(4);
    if (IN(5)) {
        { pg8::Gemm g{MIX, W4, MP, DM, DM, DM / 64}; pg8::StaticOrder S; S.init(MP, DM, G, bid);
          EpiResid<true, true, false> E{nullptr, nullptr, XB, SSQC, 1.0f};
          pg8::gemm_phase<EpiResid<true, true, false>, pg8::StaticOrder, true, true>(L, g, S, E, wave); }
        { pg8::Gemm g{MIX + (size_t)MP * DM, W4, MS, DM, DM, 4}; SplitOrder S{G, bid, DM / 256}; EpiPart E{PART};
          pg8::gemm_phase<EpiPart, SplitOrder, true, true>(L, g, S, E, wave); }
    }
    SEAM(5);
    if (IN(6)) {
        {
            const int gw = bid * NWAVES + wave, NGW = G * NWAVES;
            for (int r = gw; r < MS; r += NGW) {
                f32x4 acc4[4];
#pragma unroll
                for (int j = 0; j < 4; ++j) acc4[j] = (f32x4){0.f, 0.f, 0.f, 0.f};
                for (int sl = 0; sl < DM / 256; ++sl) { const f32x4* pr = (const f32x4*)(PART + ((size_t)sl * MS + r) * DM) + lane;
#pragma unroll
                    for (int j = 0; j < 4; ++j) acc4[j] += pr[64 * j]; }
                u32x2* xb8 = (u32x2*)(XB + (size_t)(MP + r) * DM) + lane; float ssum = 0.f; f32x4 v[4];
#pragma unroll
                for (int j = 0; j < 4; ++j) { const u32x2 xv = xb8[64 * j];
                    v[j] = (f32x4){__uint_as_float(xv.x << 16), __uint_as_float(xv.x & 0xffff0000u), __uint_as_float(xv.y << 16), __uint_as_float(xv.y & 0xffff0000u)} + acc4[j];
                    ssum += (v[j][0] * v[j][0] + v[j][1] * v[j][1]) + (v[j][2] * v[j][2] + v[j][3] * v[j][3]); }
                ssum = wave_sum(ssum);
#pragma unroll
                for (int j = 0; j < 4; ++j) xb8[64 * j] = (u32x2){pkbf(v[j][0], v[j][1]), pkbf(v[j][2], v[j][3])};
                if (lane < 4) *(f32x4*)(SSQC + (size_t)(MP + r) * 16 + 4 * lane) = (f32x4){lane == 0 ? ssum : 0.f, 0.f, 0.f, 0.f};
            }
            xcd_barrier(bar, wave);
        }
        pg8::Gemm g{XB, W5, M, NFF2, DM, DM / 64}; pg8::StaticOrder S; S.init(M, NFF2, G, bid);
        EpiSwiglu<4> E{ACT, SSQC};
        pg8::gemm_phase<EpiSwiglu<4>, pg8::StaticOrder, true, true>(L, g, S, E, wave);
    }
    SEAM(6);
    if (IN(7)) {
        { pg8::Gemm g{ACT, W6, MP, DM, DFF, DFF / 64}; pg8::StaticOrder S; S.init(MP, DM, G, bid);
          EpiResid<true, false, true> E{nullptr, A.out, XB, nullptr, 0.5f};
          pg8::gemm_phase<EpiResid<true, false, true>, pg8::StaticOrder, true, true>(L, g, S, E, wave); }
        { pg8::Gemm g{ACT + (size_t)MP * DFF, W6, MS, DM, DFF, 4}; SplitOrder S{G, bid, SPLIT_NS}; EpiPart E{PART};
          pg8::gemm_phase<EpiPart, SplitOrder, true, true>(L, g, S, E, wave); }
        xcd_barrier(bar, wave);
        const int gw = bid * NWAVES + wave, NGW = G * NWAVES;
        for (int r = gw; r < MS; r += NGW) {
            f32x4 acc4[4];
#pragma unroll
            for (int j = 0; j < 4; ++j) acc4[j] = (f32x4){0.f, 0.f, 0.f, 0.f};
            for (int sl = 0; sl < SPLIT_NS; ++sl) { const f32x4* pr = (const f32x4*)(PART + ((size_t)sl * MS + r) * DM) + lane;
#pragma unroll
                for (int j = 0; j < 4; ++j) acc4[j] += pr[64 * j]; }
            const u32x2* xb8 = (const u32x2*)(XB + (size_t)(MP + r) * DM) + lane; f32x4* yo = (f32x4*)(A.out + (size_t)(MP + r) * DM) + lane;
#pragma unroll
            for (int j = 0; j < 4; ++j) { const u32x2 xv = xb8[64 * j];
                const f32x4 x2 = (f32x4){__uint_as_float(xv.x << 16), __uint_as_float(xv.x & 0xffff0000u), __uint_as_float(xv.y << 16), __uint_as_float(xv.y & 0xffff0000u)};
                yo[64 * j] = x2 + acc4[j] * 0.5f; }
        }
    }
#undef IN
#undef SEAM
#undef tid
#undef lane
}

extern "C" void kernel_launch(void* const* d_in, const int* in_sizes, int n_in, void* d_out, int out_size, void* d_ws, size_t ws_size, hipStream_t stream) {
    static int grid = 0;
    if (grid == 0) {
        if (n_in != 19 || ws_size < WS_END) { fprintf(stderr, "kernel_launch: unexpected inputs (n_in %d, ws %zu)\n", n_in, ws_size); grid = -1; return; }
        int dev = 0, cus = 0, per_cu = 0;
        (void)hipGetDevice(&dev); (void)hipDeviceGetAttribute(&cus, hipDeviceAttributeMultiprocessorCount, dev);
        if (hipFuncSetAttribute((const void*)mk_fwd, hipFuncAttributeMaxDynamicSharedMemorySize, LDS_BYTES) != hipSuccess) { fprintf(stderr, "kernel_launch: hipFuncSetAttribute failed\n"); grid = -1; return; }
        if (hipOccupancyMaxActiveBlocksPerMultiprocessor(&per_cu, (const void*)mk_fwd, NWAVES * 64, LDS_BYTES) != hipSuccess || per_cu < 1) { per_cu = 1; (void)hipGetLastError(); }
        grid = cus * per_cu;
        fprintf(stderr, "kernel_launch: grid %d (cus %d x %d)\n", grid, cus, per_cu);
    }
    if (grid < 0) return;
    (void)hipMemsetAsync((char*)d_ws + WS_CTL, 0, CTL_BYTES, stream);
    Args a{};
    a.xp = (const float*)d_in[0]; a.xs = (const float*)d_in[1]; a.ck = (const float*)d_in[2]; a.cv = (const float*)d_in[3]; a.st0 = (const float*)d_in[4];
    a.g1 = (const float*)d_in[5]; a.w1 = (const float*)d_in[6]; a.w2 = (const float*)d_in[7]; a.gm = (const float*)d_in[8]; a.win = (const float*)d_in[9];
    a.qg = (const float*)d_in[10]; a.kg = (const float*)d_in[11]; a.lbl = (const float*)d_in[12]; a.og = (const float*)d_in[13]; a.hgg = (const float*)d_in[14];
    a.wo = (const float*)d_in[15]; a.g2 = (const float*)d_in[16]; a.w5 = (const float*)d_in[17]; a.w6 = (const float*)d_in[18];
    a.out = (float*)d_out; a.ws = (unsigned char*)d_ws;
    a.ph_lo = 0; a.ph_hi = NPHASE;
    void* args[] = {&a};
    hipError_t e = hipLaunchCooperativeKernel((const void*)mk_fwd, dim3(grid), dim3(NWAVES * 64), args, LDS_BYTES, stream);
    if (e != hipSuccess) fprintf(stderr, "cooperative launch failed: %s (grid %d)\n", hipGetErrorString(e), grid);
}
```

```cpp
#include <hip/hip_runtime.h>
#include <hip/hip_cooperative_groups.h>
#include <cstdio>
#include <cstdint>
namespace cg = cooperative_groups;
__device__ __forceinline__ int lane_id() { int r; asm volatile("v_mbcnt_lo_u32_b32 %0, -1, 0\n\tv_mbcnt_hi_u32_b32 %0, -1, %0" : "=&v"(r)); return r; }
namespace pg8 {
#define PG8_LAS __attribute__((address_space(3)))
typedef unsigned short bf16_t;
typedef short bf16x8 __attribute__((ext_vector_type(8)));
typedef float f32x4 __attribute__((ext_vector_type(4)));
typedef unsigned u32x4 __attribute__((ext_vector_type(4)));
constexpr int BM = 256, BK = 64, HALF = 128, HTB = HALF * BK * 2  , STAGE_BYTES = 8 * HTB, NXCD = 8, WGM = 8;

__host__ __device__ __forceinline__ int lds_byte(int r, int c) { const int st = (r >> 4) * 2 + (c >> 5), rr = r & 15, cc = c & 31, ob = rr * 64 + cc * 2; return st * 1024 + (ob ^ (((ob >> 9) & 1) << 5)); }
__host__ __device__ __forceinline__ void stage_rc(int b, int& R, int& C) { const int st = b / 1024, sb = b % 1024, swz = sb ^ (((sb >> 9) & 1) << 5); R = (st >> 1) * 16 + swz / 64; C = (st & 1) * 32 + (swz % 64) / 2; }
__host__ __device__ __forceinline__ int perm32(int rho) { const int n = rho >> 4, i = rho & 15; return 8 * (i >> 2) + 4 * n + (i & 3); }

struct Unit { int pm, pn; int ko = 0, sl = 0; };
struct Gemm { const bf16_t* A; const bf16_t* Bt; int M, N, K, KT; };

struct StaticOrder {
    int nM, nN, nwg, G, c;
    __host__ __device__ void init(int M, int N, int G_, int c_) { nM = M / BM; nN = N / BM; nwg = nM * nN; G = G_; c = c_; }
    __host__ __device__ bool next(int i, Unit& u) const {
        const long L = (long)i * G + c; if (L >= nwg) return false;
        int wgid = (int)L; { const int q = nwg / NXCD, r = nwg % NXCD, xcd = wgid % NXCD, off = wgid / NXCD; wgid = (xcd < r ? xcd * (q + 1) : r * (q + 1) + (xcd - r) * q) + off; }
        const int nig = WGM * nN, gid = wgid / nig, fm = gid * WGM, gsz = (nM - fm) < WGM ? (nM - fm) : WGM;
        u.pm = fm + ((wgid % nig) % gsz); u.pn = (wgid % nig) / gsz; return true;
    }
    __device__ __forceinline__ void a_ready(const Unit&) const {}
    __device__ __forceinline__ void done(const Unit&) const {}
};

__device__ __forceinline__ unsigned cvt_pk_bf16(float lo, float hi) { unsigned r; asm volatile("v_cvt_pk_bf16_f32 %0, %1, %2" : "=v"(r) : "v"(lo), "v"(hi)); return r; }
typedef float f32x2 __attribute__((ext_vector_type(2)));
template <class Epi, class Sched, bool ALIGN_EPI = false, bool SP2 = false>
__device__ __forceinline__ void gemm_phase(PG8_LAS unsigned char* lds, const Gemm g, const Sched& S, const Epi& E, const int wid) {
    const int lane = lane_id(), tid = wid * 64 + lane, wr = wid >> 2, wc = wid & 3, fr = lane & 15, fq = lane >> 4;
    const int K = g.K, nt = g.KT;
    unsigned voffA[2], voffB[2];
#pragma unroll
    for (int i = 0; i < 2; ++i) { int R, C; stage_rc(tid * 16 + i * 8192, R, C); const int Rb = Epi::PERM ? ((R & ~31) + perm32(R & 31)) : R;
        voffA[i] = (unsigned)(R * K + C) * 2u; voffB[i] = (unsigned)(Rb * K + C) * 2u; }
    const size_t kstep = (size_t)(BK * 2);
    const size_t hstep = (size_t)HALF * K * 2;
    const size_t tstep = 2 * hstep;
    const unsigned ldsw = (unsigned)wid * 1024u;
    const int aoff = lds_byte(wr * 64 + fr, fq * 8), boff = lds_byte(wc * 32 + fr, fq * 8);
#define PG8_SA(b, h) (((b) * 2 + (h)) * HTB)
#define PG8_SB(b, h) ((4 + (b) * 2 + (h)) * HTB)
#define PG8_STAGE(bufoff, gbase, voff) do { _Pragma("unroll") for (int _i = 0; _i < 2; ++_i) \
        __builtin_amdgcn_global_load_lds((const unsigned*)((const char*)(gbase) + (voff)[_i]), (PG8_LAS unsigned*)(lds + (bufoff) + ldsw + _i * 8192), 16, 0, 0); } while (0)
#define PG8_LDA(dst, b, h) do { _Pragma("unroll") for (int m = 0; m < 4; ++m) _Pragma("unroll") for (int k = 0; k < 2; ++k) dst[m][k] = *(const PG8_LAS bf16x8*)(lds + PG8_SA(b, h) + aoff + m * 2048 + k * 1024); } while (0)
#define PG8_LDB(dst, b, h) do { _Pragma("unroll") for (int n = 0; n < 2; ++n) _Pragma("unroll") for (int k = 0; k < 2; ++k) dst[n][k] = *(const PG8_LAS bf16x8*)(lds + PG8_SB(b, h) + boff + n * 2048 + k * 1024); } while (0)
#define PG8_MMA(ai, bj, At, Bt) do { __builtin_amdgcn_s_setprio(1); _Pragma("unroll") for (int m = 0; m < 4; ++m) _Pragma("unroll") for (int n = 0; n < 2; ++n) _Pragma("unroll") for (int k = 0; k < 2; ++k) \
        acc[ai][bj][m][n] = __builtin_amdgcn_mfma_f32_16x16x32_bf16(Bt[n][k], At[m][k], acc[ai][bj][m][n], 0, 0, 0); __builtin_amdgcn_s_setprio(0); } while (0)
#define PG8_WAIT_V(n) asm volatile("s_waitcnt vmcnt(" #n ")" ::: "memory")
#define PG8_WAIT_L(n) asm volatile("s_waitcnt lgkmcnt(" #n ")" ::: "memory")
#define PG8_BAR __builtin_amdgcn_s_barrier()
#define PG8_SCHED __builtin_amdgcn_sched_barrier(0)
    Unit cur, nxt; int ui = 0;
    if (!S.next(0, cur)) return;
    f32x4 acc[2][2][4][2];
#pragma unroll
    for (int a = 0; a < 2; ++a)
#pragma unroll
        for (int b = 0; b < 2; ++b)
#pragma unroll
            for (int m = 0; m < 4; ++m)
#pragma unroll
                for (int n = 0; n < 2; ++n) acc[a][b][m][n] = (f32x4){0.f, 0.f, 0.f, 0.f};
    bf16x8 At[4][2], B0[2][2], B1[2][2];
    const char* cA = (const char*)g.A + (size_t)cur.pm * tstep + cur.ko; const char* cB = (const char*)g.Bt + (size_t)cur.pn * tstep + cur.ko;
    S.a_ready(cur);
    if constexpr (SP2) {
        PG8_STAGE(PG8_SB(0, 0), cB, voffB); PG8_STAGE(PG8_SB(0, 1), cB + hstep, voffB); PG8_STAGE(PG8_SA(0, 0), cA, voffA); PG8_STAGE(PG8_SA(0, 1), cA + hstep, voffA);
        if (wr == 1) PG8_BAR;
        PG8_WAIT_V(2); PG8_BAR;
        PG8_STAGE(PG8_SB(1, 0), cB + kstep, voffB); PG8_STAGE(PG8_SA(1, 0), cA + kstep, voffA); PG8_STAGE(PG8_SB(1, 1), cB + hstep + kstep, voffB);
        PG8_WAIT_V(6); PG8_BAR;
    } else {
        PG8_STAGE(PG8_SB(0, 0), cB, voffB); PG8_STAGE(PG8_SA(0, 0), cA, voffA); PG8_STAGE(PG8_SB(0, 1), cB + hstep, voffB); PG8_STAGE(PG8_SA(0, 1), cA + hstep, voffA);
        if (wr == 1) PG8_BAR;
        PG8_WAIT_V(4); PG8_BAR;
        PG8_STAGE(PG8_SB(1, 0), cB + kstep, voffB); PG8_STAGE(PG8_SA(1, 0), cA + kstep, voffA); PG8_STAGE(PG8_SB(1, 1), cB + hstep + kstep, voffB);
        PG8_WAIT_V(6); PG8_BAR;
    }
    for (;;) {
        const bool has_next = S.next(ui + 1, nxt);
        const char* nA = has_next ? (const char*)g.A + (size_t)nxt.pm * tstep + nxt.ko : cA; const char* nB = has_next ? (const char*)g.Bt + (size_t)nxt.pn * tstep + nxt.ko : cB;
        for (int t = 0; t < nt; t += 2) {
            const bool last = (t == nt - 2);
            const char* a1 = cA + (size_t)(t + 1) * kstep;
            const char* a2 = last ? nA : cA + (size_t)(t + 2) * kstep; const char* b2 = last ? nB : cB + (size_t)(t + 2) * kstep;
            const char* a3 = a2 + kstep; const char* b3 = b2 + kstep;
            if (last && has_next) S.a_ready(nxt);
            if constexpr (SP2) {
            PG8_LDB(B0, 0, 0); PG8_LDB(B1, 0, 1); PG8_SCHED; PG8_LDA(At, 0, 0); PG8_STAGE(PG8_SA(1, 1), a1 + hstep, voffA);
            PG8_WAIT_V(8); PG8_WAIT_L(0); PG8_BAR; PG8_MMA(0, 0, At, B0); PG8_MMA(0, 1, At, B1); PG8_BAR; PG8_SCHED;
            PG8_LDA(At, 0, 1); PG8_STAGE(PG8_SB(0, 0), b2, voffB); PG8_STAGE(PG8_SB(0, 1), b2 + hstep, voffB); PG8_STAGE(PG8_SA(0, 0), a2, voffA);
            PG8_WAIT_V(8); PG8_WAIT_L(0); PG8_BAR; PG8_MMA(1, 0, At, B0); PG8_MMA(1, 1, At, B1); PG8_BAR; PG8_SCHED;
            PG8_LDB(B0, 1, 0); PG8_LDB(B1, 1, 1); PG8_SCHED; PG8_LDA(At, 1, 0); PG8_STAGE(PG8_SA(0, 1), a2 + hstep, voffA);
            PG8_WAIT_V(8); PG8_WAIT_L(0); PG8_BAR; PG8_MMA(0, 0, At, B0); PG8_MMA(0, 1, At, B1); PG8_BAR; PG8_SCHED;
            PG8_LDA(At, 1, 1); PG8_STAGE(PG8_SB(1, 0), b3, voffB); PG8_STAGE(PG8_SB(1, 1), b3 + hstep, voffB); PG8_STAGE(PG8_SA(1, 0), a3, voffA);
            PG8_WAIT_V(8); PG8_WAIT_L(0); PG8_BAR; PG8_MMA(1, 0, At, B0); PG8_MMA(1, 1, At, B1); PG8_BAR; PG8_SCHED;
            } else {
            PG8_LDB(B0, 0, 0); PG8_SCHED; PG8_LDA(At, 0, 0); PG8_STAGE(PG8_SA(1, 1), a1 + hstep, voffA);
            PG8_WAIT_L(8); PG8_BAR; PG8_WAIT_L(0); PG8_MMA(0, 0, At, B0); PG8_BAR; PG8_SCHED;
            PG8_LDB(B1, 0, 1); PG8_STAGE(PG8_SB(0, 0), b2, voffB);
            PG8_BAR; PG8_WAIT_L(0); PG8_MMA(0, 1, At, B1); PG8_BAR;
            PG8_LDA(At, 0, 1); PG8_STAGE(PG8_SA(0, 0), a2, voffA);
            PG8_BAR; PG8_WAIT_L(0); PG8_MMA(1, 0, At, B0); PG8_BAR; PG8_SCHED;
            PG8_STAGE(PG8_SB(0, 1), b2 + hstep, voffB);
            PG8_WAIT_V(6); PG8_BAR; PG8_MMA(1, 1, At, B1); PG8_BAR;
            PG8_LDB(B0, 1, 0); PG8_SCHED; PG8_LDA(At, 1, 0); PG8_STAGE(PG8_SA(0, 1), a2 + hstep, voffA);
            PG8_WAIT_L(8); PG8_BAR; PG8_WAIT_L(0); PG8_MMA(0, 0, At, B0); PG8_BAR; PG8_SCHED;
            PG8_LDB(B1, 1, 1); PG8_STAGE(PG8_SB(1, 0), b3, voffB);
            PG8_BAR; PG8_WAIT_L(0); PG8_MMA(0, 1, At, B1); PG8_BAR;
            PG8_LDA(At, 1, 1); PG8_STAGE(PG8_SA(1, 0), a3, voffA);
            PG8_BAR; PG8_WAIT_L(0); PG8_MMA(1, 0, At, B0); PG8_BAR; PG8_SCHED;
            PG8_STAGE(PG8_SB(1, 1), b3 + hstep, voffB);
            PG8_WAIT_V(6); PG8_BAR; PG8_MMA(1, 1, At, B1); PG8_BAR;
            }
        }
        if constexpr (ALIGN_EPI) { if (wr == 0) PG8_BAR; }
        if constexpr (!Epi::AFTER_DRAIN) { E(acc, cur, wr, wc, fr, fq); S.done(cur); }
        if (!has_next) break;
#pragma unroll
        for (int a = 0; a < 2; ++a)
#pragma unroll
            for (int b = 0; b < 2; ++b)
#pragma unroll
                for (int m = 0; m < 4; ++m)
#pragma unroll
                    for (int n = 0; n < 2; ++n) acc[a][b][m][n] = (f32x4){0.f, 0.f, 0.f, 0.f};
        cur = nxt; cA = nA; cB = nB; ++ui;
        if constexpr (ALIGN_EPI) { if (wr == 1) PG8_BAR; }
    }
    PG8_WAIT_V(0);
    if constexpr (!ALIGN_EPI) { if (wr == 0) PG8_BAR; }
    PG8_BAR;
    if constexpr (Epi::AFTER_DRAIN) { E.fused(acc, cur, wr, wc, fr, fq, lds, wid, lane); S.done(cur); }
#undef PG8_SA
#undef PG8_SB
#undef PG8_STAGE
#undef PG8_LDA
#undef PG8_LDB
#undef PG8_MMA
#undef PG8_WAIT_V
#undef PG8_WAIT_L
#undef PG8_BAR
#undef PG8_SCHED
}
}

constexpr int DM = 1024, NB = 8, SEQ = 4096, DB = 32, DS = 32, PAST = 4096;
constexpr int MP = NB * SEQ, MS = DB * DS, M = MP + MS;
constexpr int DFF = 2816, NFF2 = 2 * DFF, NIN = 3584, HW = 512;
constexpr float EPS = 1e-6f;
constexpr int NPHASE = 8;
constexpr size_t OFF_KP = (size_t)M * DM, OFF_VP = OFF_KP + (size_t)MP * HW, OFF_SP = OFF_VP + (size_t)MP * HW, OFF_KS = OFF_SP + (size_t)NB * 4 * 16384,
                 OFF_VS = OFF_KS + (size_t)MS * HW, OFF_SS = OFF_VS + (size_t)MS * HW;
constexpr size_t MiB = 1u << 20;
constexpr size_t WS_CTL = 0, CTL_BYTES = 65536;
constexpr size_t WS_W1 = 1 * MiB, WS_W2 = 13 * MiB, WS_W3 = 19 * MiB, WS_W4 = 27 * MiB, WS_W5 = 30 * MiB, WS_W6 = 42 * MiB;
constexpr size_t WS_SSQA = 48 * MiB, WS_SSQB = 49 * MiB, WS_SSQC = 52 * MiB;
constexpr size_t WS_XB = 56 * MiB;
constexpr size_t WS_ACT = 124 * MiB;
constexpr size_t WS_Q = 308 * MiB, WS_K = 342 * MiB, WS_V = 376 * MiB, WS_HQ = 410 * MiB, WS_KIN = 444 * MiB, WS_HI = 478 * MiB, WS_HG = 512 * MiB;
constexpr size_t WS_LF = 546 * MiB;
constexpr size_t WS_MIX = 614 * MiB;
constexpr size_t WS_PART = 682 * MiB;
constexpr size_t WS_END = 728 * MiB;
static_assert(WS_V - WS_K == WS_K - WS_Q && WS_HQ - WS_V == WS_K - WS_Q && WS_KIN - WS_HQ == WS_K - WS_Q && WS_HI - WS_KIN == WS_K - WS_Q && WS_HG - WS_HI == WS_K - WS_Q, "fixed stride");
static_assert((size_t)NFF2 * DM * 2 <= 12 * MiB && (size_t)DM * DFF * 2 <= 6 * MiB && (size_t)NIN * DM * 2 <= 8 * MiB && (size_t)M * 16 * 4 <= 3 * MiB, "ws map");
static_assert((size_t)M * DM * 2 <= 68 * MiB && (size_t)M * DFF * 2 <= 184 * MiB && (size_t)M * HW * 2 <= 34 * MiB && (size_t)M * HW * 4 <= 68 * MiB, "ws map 2");

constexpr int LDS_BYTES = 147456;
constexpr int NWAVES = 8;

#define LAS __attribute__((address_space(3)))
typedef unsigned short bf16;
typedef unsigned char u8;
using pg8::f32x4; using pg8::u32x4; using pg8::bf16x8; using pg8::Unit;
typedef unsigned u32x2 __attribute__((ext_vector_type(2)));
#define MFMA16(a, b, c) __builtin_amdgcn_mfma_f32_16x16x32_bf16((a), (b), (c), 0, 0, 0)

typedef float f32x2_t __attribute__((ext_vector_type(2))); typedef __bf16 bf16x2_t __attribute__((ext_vector_type(2)));
__device__ __forceinline__ unsigned pkbf(float lo, float hi) { f32x2_t v = {lo, hi}; bf16x2_t b = __builtin_convertvector(v, bf16x2_t); return __builtin_bit_cast(unsigned, b); }
__device__ __forceinline__ u32x4 pack8(f32x4 a, f32x4 b) { u32x4 w; w.x = pkbf(a[0], a[1]); w.y = pkbf(a[2], a[3]); w.z = pkbf(b[0], b[1]); w.w = pkbf(b[2], b[3]); return w; }
__device__ __forceinline__ float bf2f(unsigned short v) { return __uint_as_float((unsigned)v << 16); }
__device__ __forceinline__ float fexp(float v) { return __builtin_amdgcn_exp2f(v * 1.44269504f); }
__device__ __forceinline__ float siluf(float v) { return v * __builtin_amdgcn_rcpf(1.f + fexp(-v)); }
__device__ __forceinline__ bf16x8 as_bf(u32x4 v) { return __builtin_bit_cast(bf16x8, v); }

template <int NP4> __device__ __forceinline__ void row_scales(const float* ssq, const Unit& u, int wr, int fr, float (&rs)[2][4]) {
#pragma unroll
    for (int ai = 0; ai < 2; ++ai)
#pragma unroll
        for (int m = 0; m < 4; ++m) {
            const int row = u.pm * 256 + ai * 128 + wr * 64 + m * 16 + fr; const f32x4* p = (const f32x4*)(ssq + (size_t)row * (4 * NP4)); float s = 0.f;
#pragma unroll
            for (int k = 0; k < NP4; ++k) { const f32x4 v = p[k]; s += (v[0] + v[1]) + (v[2] + v[3]); }
            rs[ai][m] = rsqrtf(s * (1.f / DM) + EPS);
        }
}
template <int NP4> struct EpiSwiglu {
    static constexpr bool PERM = true, AFTER_DRAIN = false;
    bf16* O; const float* ssq;
    __device__ __forceinline__ void operator()(const f32x4 (&acc)[2][2][4][2], const Unit& u, int wr, int wc, int fr, int fq) const {
        float rs[2][4]; row_scales<NP4>(ssq, u, wr, fr, rs);
        const int col0 = u.pn * 128 + wc * 32 + 8 * fq;
#pragma unroll
        for (int ai = 0; ai < 2; ++ai)
#pragma unroll
            for (int m = 0; m < 4; ++m) {
                const int row = u.pm * 256 + ai * 128 + wr * 64 + m * 16 + fr; const float s = rs[ai][m];
                f32x4 o[2];
#pragma unroll
                for (int n = 0; n < 2; ++n) { const f32x4 a = acc[ai][0][m][n] * s, b = acc[ai][1][m][n] * s;
#pragma unroll
                    for (int i = 0; i < 4; ++i) o[n][i] = siluf(a[i]) * b[i]; }
                *(u32x4*)(O + (size_t)row * DFF + col0) = pack8(o[0], o[1]);
            }
    }
};
template <bool RESB, bool WB, bool OUTF> struct EpiResid {
    static constexpr bool PERM = true, AFTER_DRAIN = false;
    const float* resid; float* out; bf16* xb; float* ssq; float alpha;
    __device__ __forceinline__ void operator()(const f32x4 (&acc)[2][2][4][2], const Unit& u, int wr, int wc, int fr, int fq) const {
        const int col0 = u.pn * 256 + wc * 32 + 8 * fq;
#pragma unroll
        for (int ai = 0; ai < 2; ++ai)
#pragma unroll
            for (int m = 0; m < 4; ++m) {
                const int row = u.pm * 256 + ai * 128 + wr * 64 + m * 16 + fr; float ss = 0.f;
#pragma unroll
                for (int bj = 0; bj < 2; ++bj) {
                    const size_t off = (size_t)row * DM + col0 + bj * 128;
                    f32x4 r0, r1;
                    if (RESB) { const u32x4 rb = *(const u32x4*)(xb + off);
                        r0 = (f32x4){__uint_as_float(rb.x << 16), __uint_as_float(rb.x & 0xffff0000u), __uint_as_float(rb.y << 16), __uint_as_float(rb.y & 0xffff0000u)};
                        r1 = (f32x4){__uint_as_float(rb.z << 16), __uint_as_float(rb.z & 0xffff0000u), __uint_as_float(rb.w << 16), __uint_as_float(rb.w & 0xffff0000u)}; }
                    else { r0 = *(const f32x4*)(resid + off); r1 = *(const f32x4*)(resid + off + 4); }
                    const f32x4 o0 = r0 + acc[ai][bj][m][0] * alpha, o1 = r1 + acc[ai][bj][m][1] * alpha;
                    if (OUTF) { *(f32x4*)(out + off) = o0; *(f32x4*)(out + off + 4) = o1; }
                    if (WB) { ss += (o0[0] * o0[0] + o0[1] * o0[1]) + (o0[2] * o0[2] + o0[3] * o0[3]) + (o1[0] * o1[0] + o1[1] * o1[1]) + (o1[2] * o1[2] + o1[3] * o1[3]);
                        *(u32x4*)(xb + off) = pack8(o0, o1); }
                }
                if (WB) { ss += __shfl_xor(ss, 16); ss += __shfl_xor(ss, 32); if (fq == 0) ssq[(size_t)row * 16 + u.pn * 4 + wc] = ss; }
            }
    }
};
constexpr int SPLIT_NS = DFF / 256;
struct SplitOrder {
    int G, c, ns;
    __device__ bool next(int i, Unit& u) const { const int L = i * G + c; if (L >= 16 * ns) return false; const int tile = L % 16, slc = L / 16; u.pm = tile >> 2; u.pn = tile & 3; u.ko = slc * 256 * 2; u.sl = slc; return true; }
    __device__ __forceinline__ void a_ready(const Unit&) const {}
    __device__ __forceinline__ void done(const Unit&) const {}
};
struct EpiPart {
    static constexpr bool PERM = true, AFTER_DRAIN = false;
    float* part;
    __device__ __forceinline__ void operator()(const f32x4 (&acc)[2][2][4][2], const Unit& u, int wr, int wc, int fr, int fq) const {
        const int col0 = u.pn * 256 + wc * 32 + 8 * fq; float* base = part + (size_t)u.sl * MS * DM;
#pragma unroll
        for (int ai = 0; ai < 2; ++ai)
#pragma unroll
            for (int m = 0; m < 4; ++m) { const int row = u.pm * 256 + ai * 128 + wr * 64 + m * 16 + fr;
#pragma unroll
                for (int bj = 0; bj < 2; ++bj) { float* p = base + (size_t)row * DM + col0 + bj * 128; *(f32x4*)p = acc[ai][bj][m][0]; *(f32x4*)(p + 4) = acc[ai][bj][m][1]; } }
    }
};
struct EpiProj {
    static constexpr bool PERM = true, AFTER_DRAIN = false;
    const float* ssq; bf16 *Qb, *Kb, *Vb, *HQ, *KIN, *HI, *HG; float* LF; float* dout; const float *qg, *kg, *lbl;
    __device__ __forceinline__ void operator()(const f32x4 (&acc)[2][2][4][2], const Unit& u, int wr, int wc, int fr, int fq) const {
        float rs[2][4]; row_scales<4>(ssq, u, wr, fr, rs);
        const int grp = u.pn >> 1, lc0 = (u.pn & 1) * 256 + wc * 64 + 8 * fq;
        const bool prompt = u.pm < (MP / 256);
        if (grp <= 1) {
            const float* gain = grp == 0 ? qg : kg; const float post = grp == 0 ? 0.125f : 1.f;
            f32x4 gv[2][2];
#pragma unroll
            for (int bj = 0; bj < 2; ++bj)
#pragma unroll
                for (int n = 0; n < 2; ++n) gv[bj][n] = *(const f32x4*)(gain + 32 * bj + 8 * fq + 4 * n) * post;
            float* fo = prompt ? dout + OFF_KP : dout + OFF_KS - (size_t)MP * HW;
#pragma unroll
            for (int ai = 0; ai < 2; ++ai)
#pragma unroll
                for (int m = 0; m < 4; ++m) {
                    const int row = u.pm * 256 + ai * 128 + wr * 64 + m * 16 + fr; const float s = rs[ai][m];
                    f32x4 v[2][2]; float ss = 0.f;
#pragma unroll
                    for (int bj = 0; bj < 2; ++bj)
#pragma unroll
                        for (int n = 0; n < 2; ++n) { v[bj][n] = acc[ai][bj][m][n] * s; const f32x4 t = v[bj][n]; ss += (t[0] * t[0] + t[1] * t[1]) + (t[2] * t[2] + t[3] * t[3]); }
                    ss += __shfl_xor(ss, 16); ss += __shfl_xor(ss, 32);
                    const float rn = rsqrtf(ss * (1.f / 64.f) + EPS);
#pragma unroll
                    for (int bj = 0; bj < 2; ++bj) {
                        const f32x4 o0 = v[bj][0] * rn * gv[bj][0], o1 = v[bj][1] * rn * gv[bj][1];
                        const size_t off = (size_t)row * HW + lc0 + 32 * bj;
                        if (grp == 0) *(u32x4*)(Qb + off) = pack8(o0, o1);
                        else { *(u32x4*)(Kb + off) = pack8(o0, o1); *(f32x4*)(fo + off) = o0; *(f32x4*)(fo + off + 4) = o1; }
                    }
                }
        } else if (grp == 4) {
            f32x4 lb[2][2];
#pragma unroll
            for (int bj = 0; bj < 2; ++bj)
#pragma unroll
                for (int n = 0; n < 2; ++n) { const int ch = lc0 + 32 * bj + 4 * n; const f32x4 l0 = *(const f32x4*)(lbl + ch), l1 = *(const f32x4*)(lbl + HW + ch);
#pragma unroll
                    for (int i = 0; i < 4; ++i) lb[bj][n][i] = 1.f / (1.f + __expf(l1[i] - l0[i])); }
#pragma unroll
            for (int ai = 0; ai < 2; ++ai)
#pragma unroll
                for (int m = 0; m < 4; ++m) {
                    const int row = u.pm * 256 + ai * 128 + wr * 64 + m * 16 + fr; const float s = rs[ai][m];
#pragma unroll
                    for (int bj = 0; bj < 2; ++bj) {
                        f32x4 lf[2], kn[2];
#pragma unroll
                        for (int n = 0; n < 2; ++n)
#pragma unroll
                            for (int i = 0; i < 4; ++i) { const float v = acc[ai][bj][m][n][i] * s, e = fexp(fminf(-v, 80.f)), sg = __builtin_amdgcn_rcpf(1.f + e), l = lb[bj][n][i];
                                lf[n][i] = 0.69314718f * __builtin_amdgcn_logf(l + (1.f - l) * sg); kn[n][i] = (1.f - l) * (e * sg); }
                        const size_t off = (size_t)row * HW + lc0 + 32 * bj;
                        *(f32x4*)(LF + off) = lf[0]; *(f32x4*)(LF + off + 4) = lf[1]; *(u32x4*)(KIN + off) = pack8(kn[0], kn[1]);
                    }
                }
        } else {
            bf16* ob = Qb + (size_t)grp * ((WS_K - WS_Q) / 2);
            const bool act = (grp == 3 || grp == 6);
            float* fo = prompt ? dout + OFF_VP : dout + OFF_VS - (size_t)MP * HW;
#pragma unroll
            for (int ai = 0; ai < 2; ++ai)
#pragma unroll
                for (int m = 0; m < 4; ++m) {
                    const int row = u.pm * 256 + ai * 128 + wr * 64 + m * 16 + fr; const float s = rs[ai][m];
#pragma unroll
                    for (int bj = 0; bj < 2; ++bj) {
                        f32x4 o0 = acc[ai][bj][m][0] * s, o1 = acc[ai][bj][m][1] * s;
                        if (act) {
#pragma unroll
                            for (int i = 0; i < 4; ++i) { o0[i] = siluf(o0[i]); o1[i] = siluf(o1[i]); } }
                        const size_t off = (size_t)row * HW + lc0 + 32 * bj;
                        *(u32x4*)(ob + off) = pack8(o0, o1);
                        if (grp == 2) { *(f32x4*)(fo + off) = o0; *(f32x4*)(fo + off + 4) = o1; }
                    }
                }
        }
    }
};

__device__ __forceinline__ float wave_sum(float v) {
#pragma unroll
    for (int o = 1; o < 64; o <<= 1) v += __shfl_xor(v, o);
    return v;
}
template <int MAP> __device__ __forceinline__ int src_col(int n) {
    if (MAP == 0) return n;
    if (MAP == 1) { const int pn = n >> 8, r = n & 255; return r < 128 ? pn * 128 + r : DFF + pn * 128 + (r - 128); }
    const int pn = n >> 8, r = n & 255, bj = r >> 7, wc = (r >> 5) & 3, j = r & 31; return pn * 256 + wc * 64 + bj * 32 + j;
}
template <int MAP> __device__ __forceinline__ void transpose_item(const float* W, int K, int N, bf16* WT, const float* kg, LAS float* scr, int item, int lane) {
    const int nblk = N / 32, kb = item / nblk, nb = item % nblk, k0 = 64 * kb, n0 = 32 * nb, sn0 = src_col<MAP>(n0);
    float wv[32];
#pragma unroll
    for (int i = 0; i < 32; ++i) { const int kk = 2 * i + (lane >> 5); wv[i] = W[(size_t)(k0 + kk) * N + sn0 + (lane & 31)]; }
#pragma unroll
    for (int i = 0; i < 32; ++i) { const int kk = 2 * i + (lane >> 5); float w = wv[i]; if (kg) w *= kg[k0 + kk]; scr[kk * 33 + (lane & 31)] = w; }
    asm volatile("s_waitcnt lgkmcnt(0)" ::: "memory");
    const int c = lane & 7;
#pragma unroll
    for (int j = 0; j < 4; ++j) { const int n = (lane >> 3) + 8 * j; const LAS float* s = scr + (8 * c) * 33 + n;
        u32x4 o; o.x = pkbf(s[0 * 33], s[1 * 33]); o.y = pkbf(s[2 * 33], s[3 * 33]); o.z = pkbf(s[4 * 33], s[5 * 33]); o.w = pkbf(s[6 * 33], s[7 * 33]);
        *(u32x4*)(WT + (size_t)(n0 + n) * K + k0 + 8 * c) = o; }
    asm volatile("s_waitcnt lgkmcnt(0)" ::: "memory");
}

typedef __attribute__((address_space(1))) unsigned gu32;
#define XB_TMO      128
#define XB_XCNT(j)  (256  + 64 * (j))
#define XB_XSUB(j)  (1280 + 64 * (j))
#define XB_XGEN(j)  (2304 + 64 * (j))
#define XB_TOP      3328
#define XB_TOPGEN   3392
#define XCD_BAR_WORDS 3456
#define XB_SPIN_CAP (1u << 18)

__device__ __forceinline__ unsigned xb_ld(unsigned* p)              { return __hip_atomic_load(p, __ATOMIC_RELAXED, __HIP_MEMORY_SCOPE_AGENT); }
__device__ __forceinline__ unsigned xb_add(unsigned* p, unsigned v) { return __hip_atomic_fetch_add(p, v, __ATOMIC_RELAXED, __HIP_MEMORY_SCOPE_AGENT); }
__device__ __forceinline__ unsigned xb_xcc_id() { return (unsigned)__builtin_amdgcn_s_getreg((3 << 11) | 20) & 0xFu; }
#define XB_SPIN(cond, bar) do { unsigned _sp = 0; while (cond) { __builtin_amdgcn_s_sleep(1); \
    if ((++_sp & 255u) == 0u) { if (xb_ld(&(bar)[XB_TMO])) break; if (_sp > XB_SPIN_CAP) { atomicAdd(&(bar)[XB_TMO], 1u); break; } } } } while (0)

struct XcdBarrier {
    unsigned* bar; unsigned x;
    volatile LAS unsigned* st;
};

__device__ __forceinline__ XcdBarrier xcd_barrier_post(unsigned* bar, volatile LAS unsigned* st, int wv) {
    XcdBarrier b; b.bar = bar; b.x = xb_xcc_id(); b.st = st;
    if (wv == 0 && lane_id() == 0) (void)xb_add(&bar[XB_XCNT(b.x)], 1u);
    return b;
}
__device__ __forceinline__ void xcd_barrier_complete(unsigned* bar, unsigned x, unsigned& nloc, unsigned& nx) {
    const unsigned G = gridDim.x * gridDim.y * gridDim.z;
    unsigned sum, cnt, mine, sp = 0u;
    for (;;) {
        sum = 0u; cnt = 0u; mine = 0u;
#pragma unroll
        for (unsigned j = 0; j < 16; ++j) { const unsigned c = xb_ld(&bar[XB_XCNT(j)]); sum += c; cnt += (c > 0u) ? 1u : 0u; mine = (j == x) ? c : mine; }
        if (sum == G) break;
        __builtin_amdgcn_s_sleep(1);
        if ((++sp & 255u) == 0u) { if (xb_ld(&bar[XB_TMO])) break; if (sp > XB_SPIN_CAP) { atomicAdd(&bar[XB_TMO], 1u); break; } }
    }
    nloc = mine > 0u ? mine : 1u; nx = cnt > 0u ? cnt : 1u;
}

__device__ __forceinline__ void xcd_barrier(const XcdBarrier& b, int wv) {
    asm volatile("s_waitcnt vmcnt(0)" ::: "memory");
    __syncthreads();
    if (wv == 0 && lane_id() == 0) {
        unsigned* bar = b.bar;
        __builtin_amdgcn_s_waitcnt(0);
        unsigned nloc = b.st[0], nx = b.st[1];
        if (nloc == 0u) { xcd_barrier_complete(bar, b.x, nloc, nx); b.st[0] = nloc; b.st[1] = nx; }
        const unsigned old = xb_add(&bar[XB_XSUB(b.x)], 1u);
        const unsigned gen = old / nloc;
        if (old + 1u == (gen + 1u) * nloc) {
            __builtin_amdgcn_fence(__ATOMIC_RELEASE, "agent");
            asm volatile("s_waitcnt vmcnt(0)" ::: "memory");
            const unsigned og = xb_add(&bar[XB_TOP], 1u);
            const unsigned tg = og / nx;
            if (og + 1u == (tg + 1u) * nx) xb_add(&bar[XB_TOPGEN], 1u);
            else XB_SPIN(xb_ld(&bar[XB_TOPGEN]) == tg, bar);
            __builtin_amdgcn_fence(__ATOMIC_ACQUIRE, "agent");
            xb_add(&bar[XB_XGEN(b.x)], 1u);
            asm volatile("s_waitcnt vmcnt(0)" ::: "memory");
        } else {
            XB_SPIN(xb_ld(&bar[XB_XGEN(b.x)]) == gen, bar);
            __builtin_amdgcn_fence(__ATOMIC_ACQUIRE, "agent");
            asm volatile("s_waitcnt vmcnt(0)" ::: "memory");
        }
    }
    __syncthreads();
}

struct Args {
    const float *xp, *xs, *ck, *cv, *st0, *g1, *w1, *w2, *gm, *win, *qg, *kg, *lbl, *og, *hgg, *wo, *g2, *w5, *w6;
    float* out; unsigned char* ws; int ph_lo, ph_hi;
};

struct ChunkRaw { u32x4 k[4]; u32x4 v[4]; };
__device__ __forceinline__ void load_chunk(ChunkRaw& r, int c, int ncache, const bf16* Kn, const bf16* Vn, const float* cK, const float* cV, int lane) {
    const int key = lane & 15, g = lane >> 4, vkey = lane >> 3, vds = lane & 7;
    if (32 * c >= ncache) {
        const int rel = 32 * c - ncache;
#pragma unroll
        for (int kt = 0; kt < 2; ++kt)
#pragma unroll
            for (int kk = 0; kk < 2; ++kk) r.k[kt * 2 + kk] = *(const u32x4*)(Kn + (size_t)(rel + 16 * kt + key) * HW + 32 * kk + 8 * g);
#pragma unroll
        for (int pi = 0; pi < 4; ++pi) r.v[pi] = *(const u32x4*)(Vn + (size_t)(rel + vkey + 8 * pi) * HW + 8 * vds);
    } else {
#pragma unroll
        for (int kt = 0; kt < 2; ++kt)
#pragma unroll
            for (int kk = 0; kk < 2; ++kk) { const float* p = cK + (size_t)(32 * c + 16 * kt + key) * HW + 32 * kk + 8 * g; r.k[kt * 2 + kk] = pack8(*(const f32x4*)p, *(const f32x4*)(p + 4)); }
#pragma unroll
        for (int pi = 0; pi < 4; ++pi) { const float* p = cV + (size_t)(32 * c + vkey + 8 * pi) * HW + 8 * vds; r.v[pi] = pack8(*(const f32x4*)p, *(const f32x4*)(p + 4)); }
    }
}
__device__ __forceinline__ void attn_unit(LAS u8* wl, const bf16* Q, const bf16* Kn, const bf16* Vn, const float* cK, const float* cV, int ncache, int qpos0, const float* ogain, bf16* out, int lane) {
    const int q = lane & 15, g = lane >> 4;
    bf16x8 qf[2];
#pragma unroll
    for (int kk = 0; kk < 2; ++kk) qf[kk] = as_bf(*(const u32x4*)(Q + (size_t)q * HW + 32 * kk + 8 * g));
    bf16x8 TA[2], ONES;
#pragma unroll
    for (int j = 0; j < 8; ++j) { const int keyp = j < 4 ? 4 * g + j : 12 + 4 * g + j; TA[0][j] = keyp > q ? (short)0x3F80 : (short)0; TA[1][j] = keyp > 16 + q ? (short)0x3F80 : (short)0; ONES[j] = (short)0x3F80; }
    f32x4 O[4];
#pragma unroll
    for (int dt = 0; dt < 4; ++dt) O[dt] = (f32x4){0.f, 0.f, 0.f, 0.f};
    float carry = 0.f;
    const int cstart = qpos0 >> 5, qpos = qpos0 + q;
#define ATT_CHUNK(R_, C_) do { \
_Pragma("unroll") \
        for (int pi = 0; pi < 4; ++pi) { LAS u8* p = wl + ((lane >> 3) + 8 * pi) * 136 + (lane & 7) * 16; *(LAS u32x2*)p = (u32x2){R_.v[pi].x, R_.v[pi].y}; *(LAS u32x2*)(p + 8) = (u32x2){R_.v[pi].z, R_.v[pi].w}; } \
        f32x4 st[2]; \
_Pragma("unroll") \
        for (int kt = 0; kt < 2; ++kt) { st[kt] = (f32x4){0.f, 0.f, 0.f, 0.f}; \
_Pragma("unroll") \
            for (int kk = 0; kk < 2; ++kk) st[kt] = MFMA16(as_bf(R_.k[kt * 2 + kk]), qf[kk], st[kt]); } \
        float ls[2][4], lk[2][4]; bool ok[2][4]; \
_Pragma("unroll") \
        for (int kt = 0; kt < 2; ++kt) \
_Pragma("unroll") \
            for (int i = 0; i < 4; ++i) { const float z = st[kt][i], L = -0.69314718f * __builtin_amdgcn_logf(1.f + fexp(-fabsf(z))); \
                ok[kt][i] = (32 * (C_) + 16 * kt + 4 * g + i) < qpos; \
                ls[kt][i] = z < 0.f ? z + L : L; lk[kt][i] = ok[kt][i] ? (z < 0.f ? L : L - z) : 0.f; } \
        u32x4 bhi, blo; \
        bhi.x = pkbf(lk[0][0], lk[0][1]); bhi.y = pkbf(lk[0][2], lk[0][3]); bhi.z = pkbf(lk[1][0], lk[1][1]); bhi.w = pkbf(lk[1][2], lk[1][3]); \
        blo.x = pkbf(lk[0][0] - __uint_as_float(bhi.x << 16), lk[0][1] - __uint_as_float(bhi.x & 0xffff0000u)); \
        blo.y = pkbf(lk[0][2] - __uint_as_float(bhi.y << 16), lk[0][3] - __uint_as_float(bhi.y & 0xffff0000u)); \
        blo.z = pkbf(lk[1][0] - __uint_as_float(bhi.z << 16), lk[1][1] - __uint_as_float(bhi.z & 0xffff0000u)); \
        blo.w = pkbf(lk[1][2] - __uint_as_float(bhi.w << 16), lk[1][3] - __uint_as_float(bhi.w & 0xffff0000u)); \
        f32x4 tail[2], tot; \
        const f32x4 z4 = (f32x4){0.f, 0.f, 0.f, 0.f}; \
_Pragma("unroll") \
        for (int kt = 0; kt < 2; ++kt) { tail[kt] = MFMA16(TA[kt], as_bf(bhi), z4); tail[kt] = MFMA16(TA[kt], as_bf(blo), tail[kt]); } \
        tot = MFMA16(ONES, as_bf(bhi), z4); tot = MFMA16(ONES, as_bf(blo), tot); \
        float w[2][4]; \
_Pragma("unroll") \
        for (int kt = 0; kt < 2; ++kt) \
_Pragma("unroll") \
            for (int i = 0; i < 4; ++i) w[kt][i] = ok[kt][i] ? fexp(ls[kt][i] + tail[kt][i] + carry) : 0.f; \
        carry += tot[0]; \
        u32x4 bw; bw.x = pkbf(w[0][0], w[0][1]); bw.y = pkbf(w[0][2], w[0][3]); bw.z = pkbf(w[1][0], w[1][1]); bw.w = pkbf(w[1][2], w[1][3]); \
        asm volatile("s_waitcnt lgkmcnt(0)" ::: "memory"); \
_Pragma("unroll") \
        for (int dt = 0; dt < 4; ++dt) { bf16x8 vf; \
_Pragma("unroll") \
            for (int j = 0; j < 8; ++j) { const int keyp = j < 4 ? 4 * g + j : 12 + 4 * g + j; vf[j] = (short)*(const LAS unsigned short*)(wl + keyp * 136 + (16 * dt + q) * 2); } \
            O[dt] = MFMA16(vf, as_bf(bw), O[dt]); } \
        asm volatile("s_waitcnt lgkmcnt(0)" ::: "memory"); \
    } while (0)
    ChunkRaw bufA, bufB; load_chunk(bufA, cstart, ncache, Kn, Vn, cK, cV, lane);
    for (int c = cstart;; c -= 2) {
        load_chunk(bufB, c > 0 ? c - 1 : 0, ncache, Kn, Vn, cK, cV, lane);
        ATT_CHUNK(bufA, c);
        if (c == 0 || __all(carry < -104.f)) break;
        load_chunk(bufA, c > 1 ? c - 2 : 0, ncache, Kn, Vn, cK, cV, lane);
        ATT_CHUNK(bufB, c - 1);
        if (c == 1 || __all(carry < -104.f)) break;
    }
#undef ATT_CHUNK
    float ss = 0.f;
#pragma unroll
    for (int dt = 0; dt < 4; ++dt) ss += (O[dt][0] * O[dt][0] + O[dt][1] * O[dt][1]) + (O[dt][2] * O[dt][2] + O[dt][3] * O[dt][3]);
    ss += __shfl_xor(ss, 16); ss += __shfl_xor(ss, 32);
    const float rn = rsqrtf(ss * (1.f / 64.f) + EPS);
#pragma unroll
    for (int dt = 0; dt < 4; ++dt) { const int d0 = 16 * dt + 4 * g; const f32x4 gn = *(const f32x4*)(ogain + d0), o = O[dt] * rn * gn;
        *(u32x2*)(out + (size_t)q * DM + d0) = (u32x2){pkbf(o[0], o[1]), pkbf(o[2], o[3])}; }
}

__device__ __forceinline__ void attn_unit2(LAS u8* wl, const bf16* Q, const bf16* Kn, const bf16* Vn, const float* cK, const float* cV, int ncache, int qpos0, const float* ogain, bf16* out, int lane) {
    const int q = lane & 15, g = lane >> 4;
    bf16x8 qf[2][2];
#pragma unroll
    for (int T = 0; T < 2; ++T)
#pragma unroll
        for (int kk = 0; kk < 2; ++kk) qf[T][kk] = as_bf(*(const u32x4*)(Q + (size_t)(16 * T + q) * HW + 32 * kk + 8 * g));
    bf16x8 TA[2], ONES;
#pragma unroll
    for (int j = 0; j < 8; ++j) { const int keyp = j < 4 ? 4 * g + j : 12 + 4 * g + j; TA[0][j] = keyp > q ? (short)0x3F80 : (short)0; TA[1][j] = keyp > 16 + q ? (short)0x3F80 : (short)0; ONES[j] = (short)0x3F80; }
    f32x4 O[2][4];
#pragma unroll
    for (int T = 0; T < 2; ++T)
#pragma unroll
        for (int dt = 0; dt < 4; ++dt) O[T][dt] = (f32x4){0.f, 0.f, 0.f, 0.f};
    float carry[2] = {0.f, 0.f};
    const int cstart = qpos0 >> 5;
#define ATT_CHUNK2(R_, C_) do { \
        _Pragma("unroll") for (int pi = 0; pi < 4; ++pi) { LAS u8* p = wl + ((lane >> 3) + 8 * pi) * 136 + (lane & 7) * 16; *(LAS u32x2*)p = (u32x2){R_.v[pi].x, R_.v[pi].y}; *(LAS u32x2*)(p + 8) = (u32x2){R_.v[pi].z, R_.v[pi].w}; } \
        asm volatile("s_waitcnt lgkmcnt(0)" ::: "memory"); \
        bf16x8 vf[4]; \
        _Pragma("unroll") for (int dt = 0; dt < 4; ++dt) \
            _Pragma("unroll") for (int j = 0; j < 8; ++j) { const int keyp = j < 4 ? 4 * g + j : 12 + 4 * g + j; vf[dt][j] = (short)*(const LAS unsigned short*)(wl + keyp * 136 + (16 * dt + q) * 2); } \
        _Pragma("unroll") for (int T = 0; T < 2; ++T) { \
            const int qpos = qpos0 + 16 * T + q; \
            f32x4 st[2]; \
            _Pragma("unroll") for (int kt = 0; kt < 2; ++kt) { st[kt] = (f32x4){0.f, 0.f, 0.f, 0.f}; \
                _Pragma("unroll") for (int kk = 0; kk < 2; ++kk) st[kt] = MFMA16(as_bf(R_.k[kt * 2 + kk]), qf[T][kk], st[kt]); } \
            float ls[2][4], lk[2][4]; bool ok[2][4]; \
            _Pragma("unroll") for (int kt = 0; kt < 2; ++kt) \
                _Pragma("unroll") for (int i = 0; i < 4; ++i) { const float z = st[kt][i], L = -0.69314718f * __builtin_amdgcn_logf(1.f + fexp(-fabsf(z))); \
                    ok[kt][i] = (32 * (C_) + 16 * kt + 4 * g + i) < qpos; \
                    ls[kt][i] = z < 0.f ? z + L : L; lk[kt][i] = ok[kt][i] ? (z < 0.f ? L : L - z) : 0.f; } \
            u32x4 bhi, blo; \
            bhi.x = pkbf(lk[0][0], lk[0][1]); bhi.y = pkbf(lk[0][2], lk[0][3]); bhi.z = pkbf(lk[1][0], lk[1][1]); bhi.w = pkbf(lk[1][2], lk[1][3]); \
            blo.x = pkbf(lk[0][0] - __uint_as_float(bhi.x << 16), lk[0][1] - __uint_as_float(bhi.x & 0xffff0000u)); \
            blo.y = pkbf(lk[0][2] - __uint_as_float(bhi.y << 16), lk[0][3] - __uint_as_float(bhi.y & 0xffff0000u)); \
            blo.z = pkbf(lk[1][0] - __uint_as_float(bhi.z << 16), lk[1][1] - __uint_as_float(bhi.z & 0xffff0000u)); \
            blo.w = pkbf(lk[1][2] - __uint_as_float(bhi.w << 16), lk[1][3] - __uint_as_float(bhi.w & 0xffff0000u)); \
            f32x4 tail[2], tot; const f32x4 z4 = (f32x4){0.f, 0.f, 0.f, 0.f}; \
            _Pragma("unroll") for (int kt = 0; kt < 2; ++kt) { tail[kt] = MFMA16(TA[kt], as_bf(bhi), z4); tail[kt] = MFMA16(TA[kt], as_bf(blo), tail[kt]); } \
            tot = MFMA16(ONES, as_bf(bhi), z4); tot = MFMA16(ONES, as_bf(blo), tot); \
            float w[2][4]; \
            _Pragma("unroll") for (int kt = 0; kt < 2; ++kt) \
                _Pragma("unroll") for (int i = 0; i < 4; ++i) w[kt][i] = ok[kt][i] ? fexp(ls[kt][i] + tail[kt][i] + carry[T]) : 0.f; \
            carry[T] += tot[0]; \
            u32x4 bw; bw.x = pkbf(w[0][0], w[0][1]); bw.y = pkbf(w[0][2], w[0][3]); bw.z = pkbf(w[1][0], w[1][1]); bw.w = pkbf(w[1][2], w[1][3]); \
            _Pragma("unroll") for (int dt = 0; dt < 4; ++dt) O[T][dt] = MFMA16(vf[dt], as_bf(bw), O[T][dt]); \
        } \
        asm volatile("" ::: "memory"); \
    } while (0)
    ChunkRaw bufA, bufB; load_chunk(bufA, cstart, ncache, Kn, Vn, cK, cV, lane);
    for (int c = cstart;; c -= 2) {
        load_chunk(bufB, c > 0 ? c - 1 : 0, ncache, Kn, Vn, cK, cV, lane);
        ATT_CHUNK2(bufA, c);
        if (c == 0 || __all(carry[0] < -104.f && carry[1] < -104.f)) break;
        load_chunk(bufA, c > 1 ? c - 2 : 0, ncache, Kn, Vn, cK, cV, lane);
        ATT_CHUNK2(bufB, c - 1);
        if (c == 1 || __all(carry[0] < -104.f && carry[1] < -104.f)) break;
    }
#undef ATT_CHUNK2
#pragma unroll
    for (int T = 0; T < 2; ++T) {
        float ss = 0.f;
#pragma unroll
        for (int dt = 0; dt < 4; ++dt) ss += (O[T][dt][0] * O[T][dt][0] + O[T][dt][1] * O[T][dt][1]) + (O[T][dt][2] * O[T][dt][2] + O[T][dt][3] * O[T][dt][3]);
        ss += __shfl_xor(ss, 16); ss += __shfl_xor(ss, 32);
        const float rn = rsqrtf(ss * (1.f / 64.f) + EPS);
#pragma unroll
        for (int dt = 0; dt < 4; ++dt) { const int d0 = 16 * dt + 4 * g; const f32x4 gn = *(const f32x4*)(ogain + d0), o = O[T][dt] * rn * gn;
            *(u32x2*)(out + (size_t)(16 * T + q) * DM + d0) = (u32x2){pkbf(o[0], o[1]), pkbf(o[2], o[3])}; }
    }
}

constexpr int HG_QD = 0, HG_KDA = 8704, HG_KDT = 17408, HG_VT = 27648, HG_OB = 37888, HG_SEG = 54784, HG_AL = 56832, HG_LDS = 57344;
constexpr int ATT_LDS0 = 65536, ATT_WL = 4352;
template <bool SEG>
__device__ __forceinline__ void hgrn_unit(LAS u8* L, int row0, int nchunks, int h, const float* S0, float* Sout, const bf16* HQ, const bf16* KIN, const float* LF, const bf16* HI, const bf16* HG,
                                          const float* ogain, bf16* MIX, float* OLOC, bf16* QDG, float* DSEG, int tid) {
    const int lane = tid & 63, w = __builtin_amdgcn_readfirstlane(tid >> 6), q16 = lane & 15, g = lane >> 4;
    const int c = tid & 127, sg = tid >> 7, nt = tid >> 4, nvs = (tid & 15) * 8;
    f32x4 S[8];
#pragma unroll
    for (int ct = 0; ct < 8; ++ct)
#pragma unroll
        for (int i = 0; i < 4; ++i) S[ct][i] = S0 ? S0[(size_t)(16 * ct + 4 * g + i) * 128 + 16 * w + q16] : 0.f;
    float lf[8]; unsigned short qv[8], kv[8], vv[8]; u32x4 gt = (u32x4){0u, 0u, 0u, 0u}; float bseg = 0.f;
#define HG_LOAD(n) do { const size_t base_ = (size_t)(row0 + 32 * (n) + 8 * sg) * HW + 128 * h + c; \
        _Pragma("unroll") for (int i = 0; i < 8; ++i) { lf[i] = LF[base_ + (size_t)i * HW]; qv[i] = HQ[base_ + (size_t)i * HW]; kv[i] = KIN[base_ + (size_t)i * HW]; vv[i] = HI[base_ + (size_t)i * HW]; } \
        if (!SEG) gt = *(const u32x4*)(HG + (size_t)(row0 + 32 * (n) + nt) * HW + 128 * h + nvs); } while (0)
    HG_LOAD(0);
    f32x4 g0 = *(const f32x4*)(ogain + nvs), g1 = *(const f32x4*)(ogain + nvs + 4);
    asm volatile("s_waitcnt vmcnt(0)" ::: "memory");
    asm volatile("" : "+v"(g0), "+v"(g1));
#pragma unroll
    for (int ct = 0; ct < 8; ++ct) asm volatile("" : "+v"(S[ct]));
    for (int n = 0; n < nchunks; ++n) {
        float a[8]; float run = 0.f;
#pragma unroll
        for (int i = 0; i < 8; ++i) { run += lf[i]; a[i] = run; }
        ((LAS float*)(L + HG_SEG))[sg * 128 + c] = run;
        __syncthreads();
        float off = 0.f, tot = 0.f;
#pragma unroll
        for (int s = 0; s < 4; ++s) { const float v = ((const LAS float*)(L + HG_SEG))[s * 128 + c]; tot += v; off += (s < sg) ? v : 0.f; }
        float kds[8];
#pragma unroll
        for (int i = 0; i < 8; ++i) { const float ai = a[i] + off, qf = bf2f(qv[i]), kf = bf2f(kv[i]); const int t = 8 * sg + i;
            *(LAS unsigned short*)(L + HG_QD + t * 272 + c * 2) = (unsigned short)(pkbf(qf * __expf(ai), 0.f) & 0xffffu);
            *(LAS unsigned short*)(L + HG_KDA + t * 272 + c * 2) = (unsigned short)(pkbf(kf * __expf(fminf(-ai, 80.f)), 0.f) & 0xffffu);
            if (SEG) QDG[(size_t)(row0 + 32 * n + t) * HW + 128 * h + c] = (unsigned short)(pkbf(qf * __expf(ai + bseg), 0.f) & 0xffffu);
            kds[i] = kf * __expf(tot - ai); }
        if (SEG) bseg += tot;
        { u32x4 o; o.x = pkbf(kds[0], kds[1]); o.y = pkbf(kds[2], kds[3]); o.z = pkbf(kds[4], kds[5]); o.w = pkbf(kds[6], kds[7]); *(LAS u32x4*)(L + HG_KDT + c * 80 + sg * 16) = o;
          u32x4 v; v.x = (unsigned)vv[0] | ((unsigned)vv[1] << 16); v.y = (unsigned)vv[2] | ((unsigned)vv[3] << 16); v.z = (unsigned)vv[4] | ((unsigned)vv[5] << 16); v.w = (unsigned)vv[6] | ((unsigned)vv[7] << 16);
          *(LAS u32x4*)(L + HG_VT + c * 80 + sg * 16) = v; }
        if (sg == 3) ((LAS float*)(L + HG_AL))[c] = tot;
        const u32x4 gcur = gt;
        if (n + 1 < nchunks) HG_LOAD(n + 1);
        __syncthreads();
        f32x4 at00 = (f32x4){0.f, 0.f, 0.f, 0.f}, at01 = at00, at11 = at00;
#pragma unroll
        for (int kk = 0; kk < 4; ++kk) {
            const bf16x8 ka0 = *(const LAS bf16x8*)(L + HG_KDA + q16 * 272 + kk * 64 + g * 16), ka1 = *(const LAS bf16x8*)(L + HG_KDA + (16 + q16) * 272 + kk * 64 + g * 16);
            const bf16x8 qb0 = *(const LAS bf16x8*)(L + HG_QD + q16 * 272 + kk * 64 + g * 16), qb1 = *(const LAS bf16x8*)(L + HG_QD + (16 + q16) * 272 + kk * 64 + g * 16);
            at00 = MFMA16(ka0, qb0, at00); at01 = MFMA16(ka0, qb1, at01); at11 = MFMA16(ka1, qb1, at11);
        }
#pragma unroll
        for (int i = 0; i < 4; ++i) { const bool keep = (4 * g + i) <= q16; at00[i] = keep ? at00[i] : 0.f; at11[i] = keep ? at11[i] : 0.f; }
        u32x4 b0, b1; b0.x = pkbf(at00[0], at00[1]); b0.y = pkbf(at00[2], at00[3]); b0.z = 0u; b0.w = 0u;
        b1.x = pkbf(at01[0], at01[1]); b1.y = pkbf(at01[2], at01[3]); b1.z = pkbf(at11[0], at11[1]); b1.w = pkbf(at11[2], at11[3]);
        f32x4 o0 = (f32x4){0.f, 0.f, 0.f, 0.f}, o1 = o0;
#pragma unroll
        for (int ks = 0; ks < 4; ++ks) {
            const bf16x8 sa = as_bf(pack8(S[2 * ks], S[2 * ks + 1]));
            const u32x2 l0 = *(const LAS u32x2*)(L + HG_QD + q16 * 272 + (32 * ks + 4 * g) * 2), h0 = *(const LAS u32x2*)(L + HG_QD + q16 * 272 + (32 * ks + 16 + 4 * g) * 2);
            const u32x2 l1 = *(const LAS u32x2*)(L + HG_QD + (16 + q16) * 272 + (32 * ks + 4 * g) * 2), h1 = *(const LAS u32x2*)(L + HG_QD + (16 + q16) * 272 + (32 * ks + 16 + 4 * g) * 2);
            o0 = MFMA16(sa, as_bf((u32x4){l0.x, l0.y, h0.x, h0.y}), o0); o1 = MFMA16(sa, as_bf((u32x4){l1.x, l1.y, h1.x, h1.y}), o1);
        }
        { const u32x2 vl = *(const LAS u32x2*)(L + HG_VT + (16 * w + q16) * 80 + (4 * g) * 2), vh = *(const LAS u32x2*)(L + HG_VT + (16 * w + q16) * 80 + (16 + 4 * g) * 2);
          const bf16x8 va = as_bf((u32x4){vl.x, vl.y, vh.x, vh.y});
          o0 = MFMA16(va, as_bf(b0), o0); o1 = MFMA16(va, as_bf(b1), o1); }
        if (SEG) {
            float* op = OLOC + (size_t)(row0 + 32 * n + q16) * HW + 128 * h + 16 * w + 4 * g; *(f32x4*)op = o0; *(f32x4*)(op + (size_t)16 * HW) = o1;
        } else { *(LAS f32x4*)(L + HG_OB + q16 * 528 + (16 * w + 4 * g) * 4) = o0; *(LAS f32x4*)(L + HG_OB + (16 + q16) * 528 + (16 * w + 4 * g) * 4) = o1; }
        { const bf16x8 vb = *(const LAS bf16x8*)(L + HG_VT + (16 * w + q16) * 80 + g * 16);
#pragma unroll
          for (int ct = 0; ct < 8; ++ct) { const f32x4 al = *(const LAS f32x4*)(L + HG_AL + (16 * ct + 4 * g) * 4);
#pragma unroll
              for (int i = 0; i < 4; ++i) S[ct][i] *= __expf(al[i]);
              const bf16x8 ka = *(const LAS bf16x8*)(L + HG_KDT + (16 * ct + q16) * 80 + g * 16);
              S[ct] = MFMA16(ka, vb, S[ct]); } }
        if (!SEG) {
        __syncthreads();
        { const f32x4 x0 = *(const LAS f32x4*)(L + HG_OB + nt * 528 + nvs * 4), x1 = *(const LAS f32x4*)(L + HG_OB + nt * 528 + nvs * 4 + 16);
          {
          float ss = (x0[0] * x0[0] + x0[1] * x0[1]) + (x0[2] * x0[2] + x0[3] * x0[3]) + (x1[0] * x1[0] + x1[1] * x1[1]) + (x1[2] * x1[2] + x1[3] * x1[3]);
          ss += __shfl_xor(ss, 1); ss += __shfl_xor(ss, 2); ss += __shfl_xor(ss, 4); ss += __shfl_xor(ss, 8);
          const float rn = rsqrtf(ss * (1.f / 128.f) + EPS);
          f32x4 y0 = x0 * rn * g0, y1 = x1 * rn * g1;
          y0[0] *= __uint_as_float(gcur.x << 16); y0[1] *= __uint_as_float(gcur.x & 0xffff0000u); y0[2] *= __uint_as_float(gcur.y << 16); y0[3] *= __uint_as_float(gcur.y & 0xffff0000u);
          y1[0] *= __uint_as_float(gcur.z << 16); y1[1] *= __uint_as_float(gcur.z & 0xffff0000u); y1[2] *= __uint_as_float(gcur.w << 16); y1[3] *= __uint_as_float(gcur.w & 0xffff0000u);
          *(u32x4*)(MIX + (size_t)(row0 + 32 * n + nt) * DM + HW + 128 * h + nvs) = pack8(y0, y1); } }
        }
    }
#undef HG_LOAD
#pragma unroll
    for (int ct = 0; ct < 8; ++ct)
#pragma unroll
        for (int i = 0; i < 4; ++i) Sout[(size_t)(16 * ct + 4 * g + i) * 128 + 16 * w + q16] = S[ct][i];
    if (SEG && sg == 0) DSEG[c] = bseg;
    __syncthreads();
}

__device__ __forceinline__ void hgrn_fix(LAS u8* L, int row0, int j, int h, const float* SLOC, const float* DSEG, float* Sfin, const float* OLOC, const bf16* QDG, const bf16* HG, const float* ogain, bf16* MIX, int tid) {
    const int lane = tid & 63, w = __builtin_amdgcn_readfirstlane(tid >> 6), q16 = lane & 15, g = lane >> 4, nt = tid >> 4, nvs = (tid & 15) * 8;
    f32x4 S[8];
#pragma unroll
    for (int ct = 0; ct < 8; ++ct) S[ct] = (f32x4){0.f, 0.f, 0.f, 0.f};
    for (int i = 0; i < j; ++i) {
        const float* sl = SLOC + (size_t)i * 16384 + 16 * w + q16; const float* ds = DSEG + (size_t)i * 128;
#pragma unroll
        for (int ct = 0; ct < 8; ++ct) { const f32x4 d = *(const f32x4*)(ds + 16 * ct + 4 * g);
#pragma unroll
            for (int e = 0; e < 4; ++e) S[ct][e] = S[ct][e] * __expf(d[e]) + sl[(size_t)(16 * ct + 4 * g + e) * 128]; }
    }
    bf16x8 sa[4];
#pragma unroll
    for (int ks = 0; ks < 4; ++ks) sa[ks] = as_bf(pack8(S[2 * ks], S[2 * ks + 1]));
    if (j == 7) {
        const float* sl = SLOC + (size_t)7 * 16384 + 16 * w + q16; const float* ds = DSEG + (size_t)7 * 128;
#pragma unroll
        for (int ct = 0; ct < 8; ++ct) { const f32x4 d = *(const f32x4*)(ds + 16 * ct + 4 * g);
#pragma unroll
            for (int e = 0; e < 4; ++e) Sfin[(size_t)(16 * ct + 4 * g + e) * 128 + 16 * w + q16] = S[ct][e] * __expf(d[e]) + sl[(size_t)(16 * ct + 4 * g + e) * 128]; }
    }
    const f32x4 g0 = *(const f32x4*)(ogain + nvs), g1 = *(const f32x4*)(ogain + nvs + 4);
    f32x4 po0[2], po1[2]; u32x4 pg[2]; u32x2 pq[2][16];
#define FIX_LOAD(n, K) do { const int r_ = row0 + 512 * j + 32 * (n); const size_t c0_ = (size_t)(r_ + q16) * HW + 128 * h, c1_ = (size_t)(r_ + 16 + q16) * HW + 128 * h; \
        po0[K] = *(const f32x4*)(OLOC + c0_ + 16 * w + 4 * g); po1[K] = *(const f32x4*)(OLOC + c1_ + 16 * w + 4 * g); pg[K] = *(const u32x4*)(HG + (size_t)(r_ + nt) * HW + 128 * h + nvs); \
        if (j > 0) { _Pragma("unroll") for (int ks = 0; ks < 4; ++ks) { pq[K][4 * ks + 0] = *(const u32x2*)(QDG + c0_ + 32 * ks + 4 * g); pq[K][4 * ks + 1] = *(const u32x2*)(QDG + c0_ + 32 * ks + 16 + 4 * g); \
            pq[K][4 * ks + 2] = *(const u32x2*)(QDG + c1_ + 32 * ks + 4 * g); pq[K][4 * ks + 3] = *(const u32x2*)(QDG + c1_ + 32 * ks + 16 + 4 * g); } } } while (0)
    FIX_LOAD(0, 0); FIX_LOAD(1, 1);
    for (int n2 = 0; n2 < 8; ++n2) {
        f32x4 o0[2], o1[2]; u32x4 gc[2];
#pragma unroll
        for (int K = 0; K < 2; ++K) { o0[K] = po0[K]; o1[K] = po1[K]; gc[K] = pg[K];
            if (j > 0) {
#pragma unroll
                for (int ks = 0; ks < 4; ++ks) {
                    o0[K] = MFMA16(sa[ks], as_bf((u32x4){pq[K][4 * ks + 0].x, pq[K][4 * ks + 0].y, pq[K][4 * ks + 1].x, pq[K][4 * ks + 1].y}), o0[K]);
                    o1[K] = MFMA16(sa[ks], as_bf((u32x4){pq[K][4 * ks + 2].x, pq[K][4 * ks + 2].y, pq[K][4 * ks + 3].x, pq[K][4 * ks + 3].y}), o1[K]);
                }
            } }
        if (n2 + 1 < 8) { FIX_LOAD(2 * n2 + 2, 0); FIX_LOAD(2 * n2 + 3, 1); }
#pragma unroll
        for (int K = 0; K < 2; ++K) { *(LAS f32x4*)(L + HG_OB + (32 * K + q16) * 528 + (16 * w + 4 * g) * 4) = o0[K]; *(LAS f32x4*)(L + HG_OB + (32 * K + 16 + q16) * 528 + (16 * w + 4 * g) * 4) = o1[K]; }
        __syncthreads();
#pragma unroll
        for (int K = 0; K < 2; ++K) {
          const int r = row0 + 512 * j + 32 * (2 * n2 + K); const u32x4 gcur = gc[K];
          const f32x4 x0 = *(const LAS f32x4*)(L + HG_OB + (32 * K + nt) * 528 + nvs * 4), x1 = *(const LAS f32x4*)(L + HG_OB + (32 * K + nt) * 528 + nvs * 4 + 16);
          float ss = (x0[0] * x0[0] + x0[1] * x0[1]) + (x0[2] * x0[2] + x0[3] * x0[3]) + (x1[0] * x1[0] + x1[1] * x1[1]) + (x1[2] * x1[2] + x1[3] * x1[3]);
          ss += __shfl_xor(ss, 1); ss += __shfl_xor(ss, 2); ss += __shfl_xor(ss, 4); ss += __shfl_xor(ss, 8);
          const float rn = rsqrtf(ss * (1.f / 128.f) + EPS);
          f32x4 y0 = x0 * rn * g0, y1 = x1 * rn * g1;
          y0[0] *= __uint_as_float(gcur.x << 16); y0[1] *= __uint_as_float(gcur.x & 0xffff0000u); y0[2] *= __uint_as_float(gcur.y << 16); y0[3] *= __uint_as_float(gcur.y & 0xffff0000u);
          y1[0] *= __uint_as_float(gcur.z << 16); y1[1] *= __uint_as_float(gcur.z & 0xffff0000u); y1[2] *= __uint_as_float(gcur.w << 16); y1[3] *= __uint_as_float(gcur.w & 0xffff0000u);
          *(u32x4*)(MIX + (size_t)(r + nt) * DM + HW + 128 * h + nvs) = pack8(y0, y1); }
        __syncthreads();
    }
#undef FIX_LOAD
}

__global__ void __launch_bounds__(NWAVES * 64, 2) mk_fwd(Args A) {
    extern __shared__ __attribute__((aligned(16))) unsigned char lds[];
    LAS u8* L = (LAS u8*)lds;
    const int wave = __builtin_amdgcn_readfirstlane((int)threadIdx.x >> 6);
#define tid (wave * 64 + lane_id())
#define lane lane_id()
    const int G = gridDim.x, bid = blockIdx.x;
    unsigned char* ws = A.ws;
    bf16 *W1 = (bf16*)(ws + WS_W1), *W2 = (bf16*)(ws + WS_W2), *W3 = (bf16*)(ws + WS_W3), *W4 = (bf16*)(ws + WS_W4), *W5 = (bf16*)(ws + WS_W5), *W6 = (bf16*)(ws + WS_W6);
    float *SSQA = (float*)(ws + WS_SSQA), *SSQB = (float*)(ws + WS_SSQB), *SSQC = (float*)(ws + WS_SSQC);
    bf16 *XB = (bf16*)(ws + WS_XB), *ACT = (bf16*)(ws + WS_ACT), *Qb = (bf16*)(ws + WS_Q), *Kb = (bf16*)(ws + WS_K), *Vb = (bf16*)(ws + WS_V), *HQ = (bf16*)(ws + WS_HQ),
         *KIN = (bf16*)(ws + WS_KIN), *HI = (bf16*)(ws + WS_HI), *HG = (bf16*)(ws + WS_HG), *MIX = (bf16*)(ws + WS_MIX);
    float* LF = (float*)(ws + WS_LF); float* PART = (float*)(ws + WS_PART);
    float *OLOC = (float*)(ws + WS_ACT), *SLOC = (float*)(ws + WS_ACT + 110 * MiB), *DSEG = (float*)(ws + WS_ACT + 130 * MiB); bf16* QDG = (bf16*)(ws + WS_ACT + 70 * MiB);
    unsigned* ctl = (unsigned*)(ws + WS_CTL);
    const int lo = A.ph_lo, hi = A.ph_hi;
    volatile LAS unsigned* MISC = (volatile LAS unsigned*)(L + LDS_BYTES - 256);
    if (tid < 64) MISC[tid] = 0u;
    __syncthreads();
    XcdBarrier bar; bar.bar = ctl + 4096; bar.x = 0; bar.st = nullptr;
    if (hi - lo > 1) bar = xcd_barrier_post(ctl + 4096, MISC + 8, wave);
#define IN(k) (lo <= (k) && (k) < hi)
#define SEAM(k) do { if (IN(k) && IN((k) + 1)) { if ((k) == 0) cg::this_grid().sync(); xcd_barrier(bar, wave); } } while (0)

    if (IN(0)) {
        if (bid == 0 && tid == 0) __hip_atomic_store(ctl, 0u, __ATOMIC_RELAXED, __HIP_MEMORY_SCOPE_AGENT);
        LAS float* scr = (LAS float*)(L + wave * 16384);
        const int gw = bid * NWAVES + wave, NGW = G * NWAVES;
        constexpr int I1 = (DM / 64) * (NFF2 / 32), I2 = (DFF / 64) * (DM / 32), I3 = (DM / 64) * (NIN / 32), I4 = (DM / 64) * (DM / 32);
        constexpr int NITEMS = 2 * I1 + 2 * I2 + I3 + I4;
        for (int it = gw; it < NITEMS; it += NGW) {
            int r = it;
            if (r < I1) { transpose_item<1>(A.w1, DM, NFF2, W1, A.g1, scr, r, lane); continue; } r -= I1;
            if (r < I1) { transpose_item<1>(A.w5, DM, NFF2, W5, A.g2, scr, r, lane); continue; } r -= I1;
            if (r < I2) { transpose_item<0>(A.w2, DFF, DM, W2, nullptr, scr, r, lane); continue; } r -= I2;
            if (r < I2) { transpose_item<0>(A.w6, DFF, DM, W6, nullptr, scr, r, lane); continue; } r -= I2;
            if (r < I3) { transpose_item<2>(A.win, DM, NIN, W3, A.gm, scr, r, lane); continue; } r -= I3;
            transpose_item<0>(A.wo, DM, DM, W4, nullptr, scr, r, lane);
        }
        for (int m0 = gw; m0 < M; m0 += 2 * NGW) {
            const int m1 = m0 + NGW; const bool has1 = m1 < M;
            const float* xr0 = m0 < MP ? A.xp + (size_t)m0 * DM : A.xs + (size_t)(m0 - MP) * DM;
            const float* xr1 = has1 ? (m1 < MP ? A.xp + (size_t)m1 * DM : A.xs + (size_t)(m1 - MP) * DM) : xr0;
            const int ln = lane; f32x4 v0[4], v1[4]; float s0 = 0.f, s1 = 0.f;
#pragma unroll
            for (int j = 0; j < 4; ++j) { v0[j] = ((const f32x4*)xr0)[ln + 64 * j]; v1[j] = ((const f32x4*)xr1)[ln + 64 * j]; }
#pragma unroll
            for (int j = 0; j < 4; ++j) { s0 += (v0[j][0] * v0[j][0] + v0[j][1] * v0[j][1]) + (v0[j][2] * v0[j][2] + v0[j][3] * v0[j][3]); s1 += (v1[j][0] * v1[j][0] + v1[j][1] * v1[j][1]) + (v1[j][2] * v1[j][2] + v1[j][3] * v1[j][3]); }
            s0 = wave_sum(s0); s1 = wave_sum(s1);
            u32x2* o0 = (u32x2*)(XB + (size_t)m0 * DM) + ln;
#pragma unroll
            for (int j = 0; j < 4; ++j) o0[64 * j] = (u32x2){pkbf(v0[j][0], v0[j][1]), pkbf(v0[j][2], v0[j][3])};
            if (ln == 0) *(f32x4*)(SSQA + (size_t)m0 * 4) = (f32x4){s0, 0.f, 0.f, 0.f};
            if (has1) { u32x2* o1 = (u32x2*)(XB + (size_t)m1 * DM) + ln;
#pragma unroll
                for (int j = 0; j < 4; ++j) o1[64 * j] = (u32x2){pkbf(v1[j][0], v1[j][1]), pkbf(v1[j][2], v1[j][3])};
                if (ln == 0) *(f32x4*)(SSQA + (size_t)m1 * 4) = (f32x4){s1, 0.f, 0.f, 0.f}; }
        }
        __syncthreads();
    }
    SEAM(0);
    if (IN(1)) {
        pg8::Gemm g{XB, W1, M, NFF2, DM, DM / 64}; pg8::StaticOrder S; S.init(M, NFF2, G, bid);
        EpiSwiglu<1> E{ACT, SSQA};
        pg8::gemm_phase<EpiSwiglu<1>, pg8::StaticOrder, true, true>(L, g, S, E, wave);
    }
    SEAM(1);
    if (IN(2)) {
        { pg8::Gemm g{ACT, W2, MP, DM, DFF, DFF / 64}; pg8::StaticOrder S; S.init(MP, DM, G, bid);
          EpiResid<true, true, false> E{nullptr, nullptr, XB, SSQB, 0.5f};
          pg8::gemm_phase<EpiResid<true, true, false>, pg8::StaticOrder, true, true>(L, g, S, E, wave); }
        { pg8::Gemm g{ACT + (size_t)MP * DFF, W2, MS, DM, DFF, 4}; SplitOrder S{G, bid, SPLIT_NS}; EpiPart E{PART};
          pg8::gemm_phase<EpiPart, SplitOrder, true, true>(L, g, S, E, wave); }
    }
    SEAM(2);
    if (IN(3)) {
        {
            const int gw = bid * NWAVES + wave, NGW = G * NWAVES;
            for (int r = gw; r < MS; r += NGW) {
                const f32x4* xr = (const f32x4*)(A.xs + (size_t)r * DM) + lane; f32x4 acc4[4];
#pragma unroll
                for (int j = 0; j < 4; ++j) acc4[j] = (f32x4){0.f, 0.f, 0.f, 0.f};
#pragma unroll
            for (int sl = 0; sl < SPLIT_NS; ++sl) { const f32x4* pr = (const f32x4*)(PART + ((size_t)sl * MS + r) * DM) + lane;
#pragma unroll
                    for (int j = 0; j < 4; ++j) acc4[j] += pr[64 * j]; }
                float ssum = 0.f; f32x4 v[4];
#pragma unroll
                for (int j = 0; j < 4; ++j) { v[j] = xr[64 * j] + acc4[j] * 0.5f; ssum += (v[j][0] * v[j][0] + v[j][1] * v[j][1]) + (v[j][2] * v[j][2] + v[j][3] * v[j][3]); }
                ssum = wave_sum(ssum);
                u32x2* o8 = (u32x2*)(XB + (size_t)(MP + r) * DM) + lane;
#pragma unroll
                for (int j = 0; j < 4; ++j) o8[64 * j] = (u32x2){pkbf(v[j][0], v[j][1]), pkbf(v[j][2], v[j][3])};
                if (lane < 4) *(f32x4*)(SSQB + (size_t)(MP + r) * 16 + 4 * lane) = (f32x4){lane == 0 ? ssum : 0.f, 0.f, 0.f, 0.f};
            }
            xcd_barrier(bar, wave);
        }
        pg8::Gemm g{XB, W3, M, NIN, DM, DM / 64}; pg8::StaticOrder S; S.init(M, NIN, G, bid);
        EpiProj E{SSQB, Qb, Kb, Vb, HQ, KIN, HI, HG, LF, A.out, A.qg, A.kg, A.lbl};
        pg8::gemm_phase<EpiProj, pg8::StaticOrder, true, true>(L, g, S, E, wave);
    }
    SEAM(3);
    if (IN(4)) {
        __syncthreads();
        for (int u = bid; u < 256; u += G) {
            const int ch = u >> 3, j = u & 7, b = ch >> 2, h = ch & 3;
            hgrn_unit<true>(L, b * SEQ + 512 * j, 16, h, nullptr, SLOC + (size_t)u * 16384, HQ, KIN, LF, HI, HG, A.hgg, MIX, OLOC, QDG, DSEG + (size_t)u * 128, tid);
        }
        xcd_barrier(bar, wave);
        for (int u = bid; u < 256; u += G) {
            const int ch = u >> 3, j = u & 7, b = ch >> 2, h = ch & 3;
            hgrn_fix(L, b * SEQ, j, h, SLOC + (size_t)ch * 8 * 16384, DSEG + (size_t)ch * 8 * 128, A.out + OFF_SP + (size_t)ch * 16384, OLOC, QDG, HG, A.hgg, MIX, tid);
        }
        const bool g256 = (G == 256); const int jb = bid & 7;
        for (int v = g256 ? ((jb >= 3 && jb <= 6) ? (jb - 3) * 32 + (bid >> 3) : 128) : bid; v < 128; v += G) { const int b = v >> 2, h = v & 3;
            hgrn_unit<false>(L, MP + b * DS, 1, h, A.st0 + (size_t)v * 16384, A.out + OFF_SS + (size_t)v * 16384, HQ, KIN, LF, HI, HG, A.hgg, MIX, nullptr, nullptr, nullptr, tid); }
        LAS u8* wl = L + ATT_LDS0 + wave * ATT_WL;
        constexpr int NS = DB * 8, NP = NB * 8 * (SEQ / 32);
        const int pb = g256 ? ((jb << 5) | (bid >> 3)) : bid;
        for (unsigned it_ = 0;; ++it_) {
            const unsigned id = (unsigned)(pb * NWAVES + wave) + it_ * (unsigned)(G * NWAVES);
            if (id >= (unsigned)(NS + NP)) break;
            const unsigned sid = id - 256u;
            if (sid < (unsigned)NS) { const int b = sid >> 3, h = sid & 7; const int r0 = MP + b * DS;
                attn_unit2(wl, Qb + (size_t)r0 * HW + 64 * h, Kb + (size_t)r0 * HW + 64 * h, Vb + (size_t)r0 * HW + 64 * h, A.ck + (size_t)b * PAST * HW + 64 * h, A.cv + (size_t)b * PAST * HW + 64 * h,
                           PAST, PAST, A.og, MIX + (size_t)r0 * DM + 64 * h, lane); }
            else { const int v = id < 256u ? (int)id : (int)id - NS, bh = v >> 7, qt = v & 127, b = bh >> 3, h = bh & 7; const int r0 = b * SEQ;
                attn_unit2(wl, Qb + (size_t)(r0 + 32 * qt) * HW + 64 * h, Kb + (size_t)r0 * HW + 64 * h, Vb + (size_t)r0 * HW + 64 * h, nullptr, nullptr, 0, 32 * qt, A.og, MIX + (size_t)(r0 + 32 * qt) * DM + 64 * h, lane); }
        }
        __syncthreads();
    }
    SEAM(4);
    if (IN(5)) {
        { pg8::Gemm g{MIX, W4, MP, DM, DM, DM / 64}; pg8::StaticOrder S; S.init(MP, DM, G, bid);
          EpiResid<true, true, false> E{nullptr, nullptr, XB, SSQC, 1.0f};
          pg8::gemm_phase<EpiResid<true, true, false>, pg8::StaticOrder, true, true>(L, g, S, E, wave); }
        { pg8::Gemm g{MIX + (size_t)MP * DM, W4, MS, DM, DM, 4}; SplitOrder S{G, bid, DM / 256}; EpiPart E{PART};
          pg8::gemm_phase<EpiPart, SplitOrder, true, true>(L, g, S, E, wave); }
    }
    SEAM(5);
    if (IN(6)) {
        {
            const int gw = bid * NWAVES + wave, NGW = G * NWAVES;
            for (int r = gw; r < MS; r += NGW) {
                f32x4 acc4[4];
#pragma unroll
                for (int j = 0; j < 4; ++j) acc4[j] = (f32x4){0.f, 0.f, 0.f, 0.f};
#pragma unroll
                for (int sl = 0; sl < DM / 256; ++sl) { const f32x4* pr = (const f32x4*)(PART + ((size_t)sl * MS + r) * DM) + lane;
#pragma unroll
                    for (int j = 0; j < 4; ++j) acc4[j] += pr[64 * j]; }
                u32x2* xb8 = (u32x2*)(XB + (size_t)(MP + r) * DM) + lane; float ssum = 0.f; f32x4 v[4];
#pragma unroll
                for (int j = 0; j < 4; ++j) { const u32x2 xv = xb8[64 * j];
                    v[j] = (f32x4){__uint_as_float(xv.x << 16), __uint_as_float(xv.x & 0xffff0000u), __uint_as_float(xv.y << 16), __uint_as_float(xv.y & 0xffff0000u)} + acc4[j];
                    ssum += (v[j][0] * v[j][0] + v[j][1] * v[j][1]) + (v[j][2] * v[j][2] + v[j][3] * v[j][3]); }
                ssum = wave_sum(ssum);
#pragma unroll
                for (int j = 0; j < 4; ++j) xb8[64 * j] = (u32x2){pkbf(v[j][0], v[j][1]), pkbf(v[j][2], v[j][3])};
                if (lane < 4) *(f32x4*)(SSQC + (size_t)(MP + r) * 16 + 4 * lane) = (f32x4){lane == 0 ? ssum : 0.f, 0.f, 0.f, 0.f};
            }
            xcd_barrier(bar, wave);
        }
        pg8::Gemm g{XB, W5, M, NFF2, DM, DM / 64}; pg8::StaticOrder S; S.init(M, NFF2, G, bid);
        EpiSwiglu<4> E{ACT, SSQC};
        pg8::gemm_phase<EpiSwiglu<4>, pg8::StaticOrder, true, true>(L, g, S, E, wave);
    }
    SEAM(6);
    if (IN(7)) {
        { pg8::Gemm g{ACT, W6, MP, DM, DFF, DFF / 64}; pg8::StaticOrder S; S.init(MP, DM, G, bid);
          EpiResid<true, false, true> E{nullptr, A.out, XB, nullptr, 0.5f};
          pg8::gemm_phase<EpiResid<true, false, true>, pg8::StaticOrder, true, true>(L, g, S, E, wave); }
        { pg8::Gemm g{ACT + (size_t)MP * DFF, W6, MS, DM, DFF, 4}; SplitOrder S{G, bid, SPLIT_NS}; EpiPart E{PART};
          pg8::gemm_phase<EpiPart, SplitOrder, true, true>(L, g, S, E, wave); }
        xcd_barrier(bar, wave);
        const int gw = bid * NWAVES + wave, NGW = G * NWAVES;
        for (int r = gw; r < MS; r += NGW) {
            f32x4 acc4[4];
#pragma unroll
            for (int j = 0; j < 4; ++j) acc4[j] = (f32x4){0.f, 0.f, 0.f, 0.f};
#pragma unroll
            for (int sl = 0; sl < SPLIT_NS; ++sl) { const f32x4* pr = (const f32x4*)(PART + ((size_t)sl * MS + r) * DM) + lane;
#pragma unroll
                for (int j = 0; j < 4; ++j) acc4[j] += pr[64 * j]; }
            const u32x2* xb8 = (const u32x2*)(XB + (size_t)(MP + r) * DM) + lane; f32x4* yo = (f32x4*)(A.out + (size_t)(MP + r) * DM) + lane;
#pragma unroll
            for (int j = 0; j < 4; ++j) { const u32x2 xv = xb8[64 * j];
                const f32x4 x2 = (f32x4){__uint_as_float(xv.x << 16), __uint_as_float(xv.x & 0xffff0000u), __uint_as_float(xv.y << 16), __uint_as_float(xv.y & 0xffff0000u)};
                yo[64 * j] = x2 + acc4[j] * 0.5f; }
        }
    }
#undef IN
#undef SEAM
#undef tid
#undef lane
}

extern "C" void kernel_launch(void* const* d_in, const int* in_sizes, int n_in, void* d_out, int out_size, void* d_ws, size_t ws_size, hipStream_t stream) {
    static int grid = 0;
    if (grid == 0) {
        if (n_in != 19 || ws_size < WS_END) { fprintf(stderr, "kernel_launch: unexpected inputs (n_in %d, ws %zu)\n", n_in, ws_size); grid = -1; return; }
        int dev = 0, cus = 0, per_cu = 0;
        (void)hipGetDevice(&dev); (void)hipDeviceGetAttribute(&cus, hipDeviceAttributeMultiprocessorCount, dev);
        if (hipFuncSetAttribute((const void*)mk_fwd, hipFuncAttributeMaxDynamicSharedMemorySize, LDS_BYTES) != hipSuccess) { fprintf(stderr, "kernel_launch: hipFuncSetAttribute failed\n"); grid = -1; return; }
        if (hipOccupancyMaxActiveBlocksPerMultiprocessor(&per_cu, (const void*)mk_fwd, NWAVES * 64, LDS_BYTES) != hipSuccess || per_cu < 1) { per_cu = 1; (void)hipGetLastError(); }
        grid = cus * per_cu;
        fprintf(stderr, "kernel_launch: grid %d (cus %d x %d)\n", grid, cus, per_cu);
    }
    if (grid < 0) return;
    (void)hipMemsetAsync((char*)d_ws + WS_CTL, 0, CTL_BYTES, stream);
    Args a{};
    a.xp = (const float*)d_in[0]; a.xs = (const float*)d_in[1]; a.ck = (const float*)d_in[2]; a.cv = (const float*)d_in[3]; a.st0 = (const float*)d_in[4];
    a.g1 = (const float*)d_in[5]; a.w1 = (const float*)d_in[6]; a.w2 = (const float*)d_in[7]; a.gm = (const float*)d_in[8]; a.win = (const float*)d_in[9];
    a.qg = (const float*)d_in[10]; a.kg = (const float*)d_in[11]; a.lbl = (const float*)d_in[12]; a.og = (const float*)d_in[13]; a.hgg = (const float*)d_in[14];
    a.wo = (const float*)d_in[15]; a.g2 = (const float*)d_in[16]; a.w5 = (const float*)d_in[17]; a.w6 = (const float*)d_in[18];
    a.out = (float*)d_out; a.ws = (unsigned char*)d_ws;
    a.ph_lo = 0; a.ph_hi = NPHASE;
    void* args[] = {&a};
    hipError_t e = hipLaunchCooperativeKernel((const void*)mk_fwd, dim3(grid), dim3(NWAVES * 64), args, LDS_BYTES, stream);
    if (e != hipSuccess) fprintf(stderr, "cooperative launch failed: %s (grid %d)\n", hipGetErrorString(e), grid);
}
```
